# Optimizing an MI355X kernel written in HIP

```python
import jax, jax.numpy as jnp
from jax import lax
import numpy as np

D_MODEL = 2048
BATCH = 2
SEQ = 8192
DEPTH = 4

HEAD_DIM = 128
ROPE_THETA = 10000.0
GRID_W = 64
BLOCK = 128
EPS = 1e-6
NEG_INF = -1e30
A_HEADS = 4
A_KV = 2
A_WINDOW = 128
B_HEADS = 4
B_KV = 4
B_PATTERNS = ((128, 1), (512, 4), (2048, 16))
C_HEADS = 4
C_KV = 2
D_HEADS = 4
D_KV = 4
NA_ROWS = 8
NA_COLS = 16

MIXER_HEADS = ((A_HEADS, A_KV), (B_HEADS, B_KV), (C_HEADS, C_KV), (D_HEADS, D_KV))
N_BRANCH = 4
BRANCH_W = A_HEADS * HEAD_DIM
IN_COLS = sum((2 * h + 2 * kv) * HEAD_DIM for h, kv in MIXER_HEADS)

kernel_name = "hybrid_gated_parallel_mixers_encoder"


def rms_norm(x, g):
    xf = x.astype(jnp.float32)
    y = xf * lax.rsqrt(jnp.mean(xf * xf, axis=-1, keepdims=True) + EPS)
    return (y * g.astype(jnp.float32)).astype(x.dtype)


def rope_tables(pos, dim):
    inv = ROPE_THETA ** (-jnp.arange(0, dim, 2, dtype=jnp.float32) / dim)
    ang = pos.astype(jnp.float32)[:, None] * inv[None, :]
    ang = jnp.concatenate([ang, ang], axis=-1)
    return (jnp.cos(ang), jnp.sin(ang))


def apply_rope(x, cos, sin):
    xf = x.astype(jnp.float32)
    x1, x2 = jnp.split(xf, 2, axis=-1)
    return (xf * cos + jnp.concatenate([-x2, x1], axis=-1) * sin).astype(x.dtype)


def apply_axial_rope(x, cos_r, sin_r, cos_c, sin_c):
    half = x.shape[-1] // 2
    return jnp.concatenate([apply_rope(x[..., :half], cos_r, sin_r),
                            apply_rope(x[..., half:], cos_c, sin_c)], axis=-1)


def column_split_points():
    points, total = [], 0
    for heads, kv in MIXER_HEADS:
        for width in (heads * HEAD_DIM, kv * HEAD_DIM, kv * HEAD_DIM, heads * HEAD_DIM):
            total += width
            points.append(total)
    return points[:-1]


def to_q_heads(t, n_kv):
    b, s, _ = t.shape
    return t.reshape(b, s, n_kv, -1, HEAD_DIM).transpose(0, 2, 3, 1, 4)


def to_kv_heads(t):
    b, s, _ = t.shape
    return t.reshape(b, s, -1, HEAD_DIM).transpose(0, 2, 1, 3)


def merge_heads(y):
    return jnp.moveaxis(y, -2, 1).reshape(y.shape[0], y.shape[-2], -1)


def banded_attention(q, k, v, reach, sink=None):
    n, hkv, g, length, hd = q.shape
    blk = min(BLOCK, length)
    nb = -(-length // blk)
    lp = nb * blk
    qb = jnp.pad(q, ((0, 0), (0, 0), (0, 0), (0, lp - length), (0, 0))).reshape(n, hkv, g, nb, blk, hd)
    pad_kv = ((0, 0), (0, 0), (reach, lp - length + reach), (0, 0))
    kp = jnp.pad(k, pad_kv)
    vp = jnp.pad(v, pad_kv)
    span = blk + 2 * reach
    idx = jnp.arange(nb)[:, None] * blk + jnp.arange(span)[None, :]
    kband = kp[:, :, idx]
    vband = vp[:, :, idx]
    kpos = (idx - reach)[:, None, :]
    qpos = (jnp.arange(nb)[:, None] * blk + jnp.arange(blk)[None, :])[:, :, None]
    mask = (jnp.abs(qpos - kpos) <= reach) & (kpos >= 0) & (kpos < length)
    s = jnp.einsum('nhgbqd,nhbkd->nhgbqk', qb, kband).astype(jnp.float32) * (hd ** -0.5)
    s = jnp.where(mask, s, NEG_INF)
    m = jnp.max(s, axis=-1)
    if sink is not None:
        sink_b = sink.astype(jnp.float32)[None, :, :, None, None]
        m = jnp.maximum(m, sink_b)
    p = jnp.exp(s - m[..., None])
    den = jnp.sum(p, axis=-1)
    if sink is not None:
        den = den + jnp.exp(sink_b - m)
    o = jnp.einsum('nhgbqk,nhbkd->nhgbqd', p.astype(v.dtype), vband).astype(jnp.float32) / den[..., None]
    o = o.reshape(n, hkv, g, lp, hd)[:, :, :, :length].astype(q.dtype)
    lse = (m + jnp.log(den)).reshape(n, hkv, g, lp)[..., :length]
    return o, lse


def dilated_attention(q, k, v):
    bsz, hkv, g, seq, hd = q.shape
    outs, lses = [], []
    for window, dil in B_PATTERNS:
        reach = (window // 2) // dil
        length = seq // dil
        qd = q.reshape(bsz, hkv, g, length, dil, hd).transpose(0, 4, 1, 2, 3, 5).reshape(bsz * dil, hkv, g, length, hd)
        kd = k.reshape(bsz, hkv, length, dil, hd).transpose(0, 3, 1, 2, 4).reshape(bsz * dil, hkv, length, hd)
        vd = v.reshape(bsz, hkv, length, dil, hd).transpose(0, 3, 1, 2, 4).reshape(bsz * dil, hkv, length, hd)
        o, lse = banded_attention(qd, kd, vd, reach)
        outs.append(o.reshape(bsz, dil, hkv, g, length, hd).transpose(0, 2, 3, 4, 1, 5).reshape(bsz, hkv, g, seq, hd))
        lses.append(lse.reshape(bsz, dil, hkv, g, length).transpose(0, 2, 3, 4, 1).reshape(bsz, hkv, g, seq))
    w = jax.nn.softmax(jnp.stack(lses, axis=0), axis=0)
    return jnp.sum(w[..., None] * jnp.stack(outs, axis=0).astype(jnp.float32), axis=0).astype(q.dtype)


def dense_block_attention(q, k, v):
    bsz, hkv, g, seq, hd = q.shape
    nb = seq // BLOCK
    qb = jnp.moveaxis(q.reshape(bsz, hkv, g, nb, BLOCK, hd), 3, 0)

    def attend(qi):
        s = jnp.einsum('nhgqd,nhkd->nhgqk', qi, k).astype(jnp.float32) * (hd ** -0.5)
        p = jax.nn.softmax(s, axis=-1)
        return jnp.einsum('nhgqk,nhkd->nhgqd', p.astype(v.dtype), v)

    o = lax.map(attend, qb)
    return jnp.moveaxis(o, 0, 3).reshape(bsz, hkv, g, seq, hd)


def neighbourhood_attention(q, k, v, rel_bias, rows):
    bsz, heads, seq, hd = q.shape
    kr = min(NA_ROWS, rows)
    kc = min(NA_COLS, GRID_W)
    qg = q.reshape(bsz, heads, rows, GRID_W, hd)
    kg = k.reshape(bsz, heads, rows, GRID_W, hd)
    vg = v.reshape(bsz, heads, rows, GRID_W, hd)
    r = jnp.arange(rows)
    col = jnp.arange(GRID_W)
    row_start = jnp.clip(r - kr // 2, 0, rows - kr)
    row_idx = row_start[:, None] + jnp.arange(kr)[None, :]
    col_start = jnp.clip(col - kc // 2, 0, GRID_W - kc)
    col_mask = (col[None, :] >= col_start[:, None]) & (col[None, :] < col_start[:, None] + kc)
    kblk = kg[:, :, row_idx].reshape(bsz, heads, rows, kr * GRID_W, hd)
    vblk = vg[:, :, row_idx].reshape(bsz, heads, rows, kr * GRID_W, hd)
    dr = row_idx - r[:, None]
    dc = jnp.clip(col[None, :] - col[:, None], -(NA_COLS - 1), NA_COLS - 1)
    bias = rel_bias[:, (dr + NA_ROWS - 1)[:, None, :, None], (dc + NA_COLS - 1)[None, :, None, :]]
    bias = bias.reshape(heads, rows, GRID_W, kr * GRID_W).astype(jnp.float32)
    mask = jnp.broadcast_to(col_mask[:, None, :], (GRID_W, kr, GRID_W)).reshape(GRID_W, kr * GRID_W)
    s = jnp.einsum('bhrqd,bhrkd->bhrqk', qg, kblk).astype(jnp.float32) * (hd ** -0.5) + bias
    s = jnp.where(mask, s, NEG_INF)
    p = jax.nn.softmax(s, axis=-1)
    o = jnp.einsum('bhrqk,bhrkd->bhrqd', p.astype(v.dtype), vblk)
    return o.reshape(bsz, heads, seq, hd)


def setup_inputs(seed: int = 0) -> dict:
    key = jax.random.key(seed)
    ks = jax.random.split(key, 14)
    nrm = jax.random.normal
    f32 = jnp.float32
    return {
        "x": nrm(ks[0], (BATCH, SEQ, D_MODEL), f32),
        "c": nrm(ks[1], (BATCH, D_MODEL), f32),
        "norm_g": 1.0 + 0.02 * nrm(ks[2], (DEPTH, D_MODEL), f32),
        "w_ada": nrm(ks[3], (DEPTH, D_MODEL, 3 * D_MODEL), f32) * D_MODEL ** -0.5,
        "b_ada": 0.01 * nrm(ks[4], (DEPTH, 3 * D_MODEL), f32),
        "w_in": nrm(ks[5], (DEPTH, D_MODEL, IN_COLS), f32) * D_MODEL ** -0.5,
        "a_sink": nrm(ks[6], (DEPTH, A_HEADS), f32),
        "c_q_norm": 1.0 + 0.02 * nrm(ks[7], (DEPTH, HEAD_DIM), f32),
        "c_k_norm": 1.0 + 0.02 * nrm(ks[8], (DEPTH, HEAD_DIM), f32),
        "d_rel_bias": 0.1 * nrm(ks[9], (DEPTH, D_HEADS, 2 * NA_ROWS - 1, 2 * NA_COLS - 1), f32),
        "w_gate_merge": nrm(ks[10], (DEPTH, D_MODEL, N_BRANCH * D_MODEL), f32) * D_MODEL ** -0.5,
        "w_branch": nrm(ks[11], (DEPTH, N_BRANCH, BRANCH_W, D_MODEL), f32) * BRANCH_W ** -0.5,
        "w_out": nrm(ks[12], (DEPTH, D_MODEL, D_MODEL), f32) * D_MODEL ** -0.5,
        "final_g": 1.0 + 0.02 * nrm(ks[13], (D_MODEL,), f32),
    }


def reference(x, c, norm_g, w_ada, b_ada, w_in, a_sink, c_q_norm, c_k_norm, d_rel_bias, w_gate_merge, w_branch, w_out, final_g):
    bsz, seq, dm = x.shape
    rows = seq // GRID_W
    pos = jnp.arange(seq, dtype=jnp.int32)
    cos1, sin1 = rope_tables(pos, HEAD_DIM)
    axial = rope_tables(pos // GRID_W, HEAD_DIM // 2) + rope_tables(pos % GRID_W, HEAD_DIM // 2)
    split_points = column_split_points()
    cond = jax.nn.silu(c)
    for layer in range(DEPTH):
        shift, scale, gate = jnp.split(cond @ w_ada[layer] + b_ada[layer], 3, axis=-1)
        h = rms_norm(x, norm_g[layer]) * (1.0 + scale[:, None, :]) + shift[:, None, :]
        (qa, ka, va, ga, qb, kb, vb, gb, qc, kc, vc, gc, qd, kd, vd, gd) = jnp.split(h @ w_in[layer], split_points, axis=-1)
        ya, _ = banded_attention(apply_rope(to_q_heads(qa, A_KV), cos1, sin1),
                                 apply_rope(to_kv_heads(ka), cos1, sin1), to_kv_heads(va),
                                 A_WINDOW, a_sink[layer].reshape(A_KV, A_HEADS // A_KV))
        yb = dilated_attention(apply_rope(to_q_heads(qb, B_KV), cos1, sin1),
                               apply_rope(to_kv_heads(kb), cos1, sin1), to_kv_heads(vb))
        yc = dense_block_attention(apply_axial_rope(rms_norm(to_q_heads(qc, C_KV), c_q_norm[layer]), *axial),
                                   apply_axial_rope(rms_norm(to_kv_heads(kc), c_k_norm[layer]), *axial),
                                   to_kv_heads(vc))
        yd = neighbourhood_attention(to_kv_heads(qd), to_kv_heads(kd), to_kv_heads(vd), d_rel_bias[layer], rows)
        branches = jnp.stack([merge_heads(ya) * jax.nn.silu(ga), merge_heads(yb) * jax.nn.silu(gb),
                              merge_heads(yc) * jax.nn.silu(gc), merge_heads(yd) * jax.nn.silu(gd)], axis=2)
        proj = jnp.einsum('bsnw,nwd->bsnd', branches, w_branch[layer])
        merge_gate = jax.nn.sigmoid((h @ w_gate_merge[layer]).reshape(bsz, seq, N_BRANCH, dm))
        x = x + gate[:, None, :] * (jnp.sum(merge_gate * proj, axis=2) @ w_out[layer])
    return rms_norm(x, final_g)
```

```cpp
#include <hip/hip_runtime.h>
#include <hip/hip_bf16.h>
#include <hip/hip_cooperative_groups.h>
#include <cstdio>
#include <cstdint>
#include <cmath>
namespace cg = cooperative_groups;

#define LAS __attribute__((address_space(3)))
typedef unsigned short bf16_t;
typedef short bf16x8 __attribute__((ext_vector_type(8)));
typedef short s16x4 __attribute__((ext_vector_type(4)));
typedef float f32x4 __attribute__((ext_vector_type(4)));
typedef float f32x2 __attribute__((ext_vector_type(2)));
typedef float f32x16 __attribute__((ext_vector_type(16)));
typedef unsigned u32x4 __attribute__((ext_vector_type(4)));
typedef unsigned u32x2 __attribute__((ext_vector_type(2)));

__constant__ float INV64[64] = {1.000000000e+00f, 8.659643531e-01f, 7.498942018e-01f, 6.493816376e-01f, 5.623413324e-01f, 4.869675338e-01f, 4.216965139e-01f, 3.651741147e-01f, 3.162277639e-01f, 2.738419771e-01f, 2.371373773e-01f, 2.053525001e-01f, 1.778279394e-01f, 1.539926529e-01f, 1.333521456e-01f, 1.154781953e-01f, 1.000000015e-01f, 8.659642935e-02f, 7.498942316e-02f, 6.493816525e-02f, 5.623413250e-02f, 4.869675264e-02f, 4.216964915e-02f, 3.651741147e-02f, 3.162277490e-02f, 2.738419548e-02f, 2.371373773e-02f, 2.053525113e-02f, 1.778279431e-02f, 1.539926510e-02f, 1.333521400e-02f, 1.154781971e-02f, 9.999999776e-03f, 8.659643121e-03f, 7.498942316e-03f, 6.493816152e-03f, 5.623413250e-03f, 4.869675264e-03f, 4.216964822e-03f, 3.651741194e-03f, 3.162277630e-03f, 2.738419687e-03f, 2.371373819e-03f, 2.053525066e-03f, 1.778279431e-03f, 1.539926510e-03f, 1.333521446e-03f, 1.154782018e-03f, 1.000000047e-03f, 8.659643354e-04f, 7.498941850e-04f, 6.493816036e-04f, 5.623413017e-04f, 4.869675322e-04f, 4.216965172e-04f, 3.651741135e-04f, 3.162277571e-04f, 2.738419571e-04f, 2.371373703e-04f, 2.053525095e-04f, 1.778279402e-04f, 1.539926598e-04f, 1.333521504e-04f, 1.154782003e-04f};
__constant__ float INV32[32] = {1.000000000e+00f, 7.498942018e-01f, 5.623413324e-01f, 4.216965139e-01f, 3.162277639e-01f, 2.371373773e-01f, 1.778279394e-01f, 1.333521456e-01f, 1.000000015e-01f, 7.498942316e-02f, 5.623413250e-02f, 4.216964915e-02f, 3.162277490e-02f, 2.371373773e-02f, 1.778279431e-02f, 1.333521400e-02f, 9.999999776e-03f, 7.498942316e-03f, 5.623413250e-03f, 4.216964822e-03f, 3.162277630e-03f, 2.371373819e-03f, 1.778279431e-03f, 1.333521446e-03f, 1.000000047e-03f, 7.498941850e-04f, 5.623413017e-04f, 4.216965172e-04f, 3.162277571e-04f, 2.371373703e-04f, 1.778279402e-04f, 1.333521504e-04f};

constexpr int DM = 2048, SEQ = 8192, NB = 2, NTOK = NB * SEQ, DEPTH = 4;
constexpr int INC = 7168, GMC = 8192, N1 = INC + GMC;
constexpr float EPS = 1e-6f;
constexpr int QA = 0, KA = 512, VA = 768, GA = 1024, QB_ = 1536, KB_ = 2048, VB_ = 2560, GB_ = 3072, QC = 3584, KC = 4096, VC = 4352, GC = 4608, QD = 5120, KD = 5632, VD = 6144, GD = 6656;

constexpr size_t WS_WT1 = 0;
constexpr size_t WS_WT2 = WS_WT1 + (size_t)DEPTH * N1 * DM * 2;
constexpr size_t WS_WT3 = WS_WT2 + (size_t)DEPTH * DM * DM * 2;
constexpr size_t WS_H = WS_WT3 + (size_t)DEPTH * DM * DM * 2;
constexpr size_t WS_QKVG = WS_H + (size_t)NTOK * DM * 2;
constexpr size_t WS_MG = WS_QKVG + (size_t)NTOK * INC * 2;
constexpr size_t WS_PO = WS_MG + (size_t)NTOK * GMC * 2;
constexpr size_t WS_PLSE = WS_PO + (size_t)3 * NTOK * 512 * 2;
constexpr size_t WS_ADA = WS_PLSE + (size_t)3 * NTOK * 4 * 4;
constexpr size_t WS_END = WS_ADA + (size_t)DEPTH * NB * 3 * DM * 4;

__device__ __forceinline__ unsigned cvt_pk_bf16(float lo, float hi) { unsigned r; asm volatile("v_cvt_pk_bf16_f32 %0, %1, %2" : "=v"(r) : "v"(lo), "v"(hi)); return r; }
__device__ __forceinline__ float bf_lo(unsigned w) { return __uint_as_float(w << 16); }
__device__ __forceinline__ float bf_hi(unsigned w) { return __uint_as_float(w & 0xffff0000u); }
__device__ __forceinline__ float bf2f(bf16_t v) { return __uint_as_float(((unsigned)v) << 16); }
__device__ __forceinline__ bf16_t f2bf(float f) { return (bf16_t)(cvt_pk_bf16(f, 0.f) & 0xffffu); }
__device__ __forceinline__ float sigmoidf_(float v) { return __builtin_amdgcn_rcpf(1.0f + __expf(-v)); }

namespace pg8 {
constexpr int BM = 256, BK = 64, HALF = 128, HTB = HALF * BK * 2, STAGE_BYTES = 8 * HTB, NXCD = 8, WGM = 8;
__host__ __device__ __forceinline__ int lds_byte(int r, int c) { const int st = (r >> 4) * 2 + (c >> 5), rr = r & 15, cc = c & 31, ob = rr * 64 + cc * 2; return st * 1024 + (ob ^ (((ob >> 9) & 1) << 5)); }
__host__ __device__ __forceinline__ void stage_rc(int b, int& R, int& C) { const int st = b / 1024, sb = b % 1024, swz = sb ^ (((sb >> 9) & 1) << 5); R = (st >> 1) * 16 + swz / 64; C = (st & 1) * 32 + (swz % 64) / 2; }
__host__ __device__ __forceinline__ int perm32(int rho) { const int n = rho >> 4, i = rho & 15; return 8 * (i >> 2) + 4 * n + (i & 3); }

struct Unit { int pm, pn, seg; };
struct Gemm { const bf16_t* A; const bf16_t* Bt; int ld; int kseg; };

struct Order {
    int nM, nN, nwg, G, c, segshift;
    __device__ void init(int M, int N, int G_, int c_, int segshift_) { nM = M / BM; nN = N / BM; nwg = nM * nN; G = G_; c = c_; segshift = segshift_; }
    __device__ bool next(int i, Unit& u) const {
        const long L = (long)(i >> segshift) * G + c; if (L >= nwg) return false;
        int wgid = (int)L; { const int q = nwg / NXCD, r = nwg % NXCD, xcd = wgid % NXCD, off = wgid / NXCD; wgid = (xcd < r ? xcd * (q + 1) : r * (q + 1) + (xcd - r) * q) + off; }
        const int nig = WGM * nN, gid = wgid / nig, fm = gid * WGM, gsz = (nM - fm) < WGM ? (nM - fm) : WGM;
        u.pm = fm + ((wgid % nig) % gsz); u.pn = (wgid % nig) / gsz; u.seg = i & ((1 << segshift) - 1); return true;
    }
};


struct EpiG1 {
    static constexpr bool PERM = true;
    bf16_t* qkvg; bf16_t* mg;
    __device__ __forceinline__ bool zero_after(const Unit&) const { return true; }
    __device__ __forceinline__ void operator()(f32x4 (&acc)[2][2][4][2], const Unit& u, int wr, int wc, int fr, int fq) const {
        const int row0 = u.pm * BM + wr * 64 + fr; const int pn = u.pn;
        int mode, ldc, colt; bf16_t* base;
        if (pn < 28) { base = qkvg; ldc = INC; colt = pn * BM; mode = (pn == 4 || pn == 5 || pn == 12 || pn == 13 || pn == 18 || pn == 19 || pn == 26 || pn == 27) ? 1 : 0; }
        else { base = mg; ldc = GMC; colt = (pn - 28) * BM; mode = 2; }
        const int col0 = colt + wc * 32 + 8 * fq;
#pragma unroll
        for (int ai = 0; ai < 2; ++ai)
#pragma unroll
            for (int m = 0; m < 4; ++m) { bf16_t* rowp = base + (size_t)(row0 + ai * HALF + m * 16) * ldc + col0;
#pragma unroll
                for (int bj = 0; bj < 2; ++bj) { f32x4 v0 = acc[ai][bj][m][0], v1 = acc[ai][bj][m][1];
                    if (mode != 0) {
#pragma unroll
                        for (int e = 0; e < 4; ++e) { const float s0 = sigmoidf_(v0[e]), s1 = sigmoidf_(v1[e]); v0[e] = (mode == 1) ? v0[e] * s0 : s0; v1[e] = (mode == 1) ? v1[e] * s1 : s1; }
                    }
                    u32x4 w; w.x = cvt_pk_bf16(v0[0], v0[1]); w.y = cvt_pk_bf16(v0[2], v0[3]); w.z = cvt_pk_bf16(v1[0], v1[1]); w.w = cvt_pk_bf16(v1[2], v1[3]);
                    *(u32x4*)(rowp + bj * HALF) = w; } }
    }
};
struct EpiG2 {
    static constexpr bool PERM = true;
    const bf16_t* mg; bf16_t* out;
    __device__ __forceinline__ bool zero_after(const Unit& u) const { return u.seg == 3; }
    __device__ __forceinline__ void operator()(f32x4 (&acc)[2][2][4][2], const Unit& u, int wr, int wc, int fr, int fq) const {
        const int row0 = u.pm * BM + wr * 64 + fr, col0 = u.pn * BM + wc * 32 + 8 * fq, seg = u.seg;
#pragma unroll
        for (int ai = 0; ai < 2; ++ai)
#pragma unroll
            for (int m = 0; m < 4; ++m) { const int row = row0 + ai * HALF + m * 16; const bf16_t* gp = mg + (size_t)row * GMC + seg * DM + col0;
#pragma unroll
                for (int bj = 0; bj < 2; ++bj) {
                    const u32x4 ga = *(const u32x4*)(gp + bj * HALF);
                    float f[8] = {bf_lo(ga.x), bf_hi(ga.x), bf_lo(ga.y), bf_hi(ga.y), bf_lo(ga.z), bf_hi(ga.z), bf_lo(ga.w), bf_hi(ga.w)};
                    if (seg < 3) { const u32x4 gb = *(const u32x4*)(gp + DM + bj * HALF);
                        const float d[8] = {bf_lo(gb.x), bf_hi(gb.x), bf_lo(gb.y), bf_hi(gb.y), bf_lo(gb.z), bf_hi(gb.z), bf_lo(gb.w), bf_hi(gb.w)};
#pragma unroll
                        for (int e = 0; e < 8; ++e) f[e] = f[e] * __builtin_amdgcn_rcpf(d[e]); }
                    f32x4 v0 = acc[ai][bj][m][0], v1 = acc[ai][bj][m][1];
                    v0[0] *= f[0]; v0[1] *= f[1]; v0[2] *= f[2]; v0[3] *= f[3]; v1[0] *= f[4]; v1[1] *= f[5]; v1[2] *= f[6]; v1[3] *= f[7];
                    acc[ai][bj][m][0] = v0; acc[ai][bj][m][1] = v1;
                    if (seg == 3) { u32x4 w; w.x = cvt_pk_bf16(v0[0], v0[1]); w.y = cvt_pk_bf16(v0[2], v0[3]); w.z = cvt_pk_bf16(v1[0], v1[1]); w.w = cvt_pk_bf16(v1[2], v1[3]);
                        *(u32x4*)(out + (size_t)row * DM + col0 + bj * HALF) = w; } } }
    }
};
struct EpiG3 {
    static constexpr bool PERM = false;
    const float* xin; float* xout; const float* gate;
    __device__ __forceinline__ bool zero_after(const Unit&) const { return true; }
    __device__ __forceinline__ void operator()(f32x4 (&acc)[2][2][4][2], const Unit& u, int wr, int wc, int fr, int fq) const {
        const int col0 = u.pn * BM + wc * 32 + 4 * fq;
        const float* gp = gate + (size_t)((u.pm * BM) >> 13) * (3 * DM) + col0;
        f32x4 gv[2][2];
#pragma unroll
        for (int bj = 0; bj < 2; ++bj)
#pragma unroll
            for (int n = 0; n < 2; ++n) gv[bj][n] = *(const f32x4*)(gp + bj * HALF + n * 16);
#pragma unroll
        for (int ai = 0; ai < 2; ++ai)
#pragma unroll
            for (int m = 0; m < 4; ++m) { const size_t off = (size_t)(u.pm * BM + ai * HALF + wr * 64 + m * 16 + fr) * DM + col0;
#pragma unroll
                for (int bj = 0; bj < 2; ++bj)
#pragma unroll
                    for (int n = 0; n < 2; ++n) { const f32x4 xo = *(const f32x4*)(xin + off + bj * HALF + n * 16);
                        *(f32x4*)(xout + off + bj * HALF + n * 16) = xo + gv[bj][n] * acc[ai][bj][m][n]; }
                if (m & 1) asm volatile("" ::: "memory"); }
    }
};

template <class Epi>
__device__ __forceinline__ void gemm_phase(LAS unsigned char* lds, const Gemm g, const Order& S, const Epi& E) {
    int tid = threadIdx.x; asm volatile("" : "+v"(tid));
    const int wid = __builtin_amdgcn_readfirstlane(tid >> 6), lane = tid & 63, wr = wid >> 2, wc = wid & 3, fr = lane & 15, fq = lane >> 4;
    const int K = g.ld, nt = g.kseg / BK;
    unsigned voffA[2], voffB[2];
#pragma unroll
    for (int i = 0; i < 2; ++i) { int R, C; stage_rc(tid * 16 + i * 8192, R, C); const int Rb = Epi::PERM ? ((R & ~31) + perm32(R & 31)) : R;
        voffA[i] = (unsigned)(R * K + C) * 2u; voffB[i] = (unsigned)(Rb * K + C) * 2u; }
    const size_t kstep = (size_t)(BK * 2);
    const size_t hstep = (size_t)HALF * K * 2;
    const size_t tstep = 2 * hstep;
    const size_t sstep = (size_t)g.kseg * 2;
    const unsigned ldsw = (unsigned)wid * 1024u;
    const int aoff = lds_byte(wr * 64 + fr, fq * 8), boff = lds_byte(wc * 32 + fr, fq * 8);
#define PG8_SA(b, h) (((b) * 2 + (h)) * HTB)
#define PG8_SB(b, h) ((4 + (b) * 2 + (h)) * HTB)
#define PG8_STAGE(bufoff, gbase, voff) do { _Pragma("unroll") for (int _i = 0; _i < 2; ++_i) \
        __builtin_amdgcn_global_load_lds((const unsigned*)((const char*)(gbase) + (voff)[_i]), (LAS unsigned*)(lds + (bufoff) + ldsw + _i * 8192), 16, 0, 0); } while (0)
#define PG8_LDA(dst, b, h) do { _Pragma("unroll") for (int m = 0; m < 4; ++m) _Pragma("unroll") for (int k = 0; k < 2; ++k) dst[m][k] = *(const LAS bf16x8*)(lds + PG8_SA(b, h) + aoff + m * 2048 + k * 1024); } while (0)
#define PG8_LDB(dst, b, h) do { _Pragma("unroll") for (int n = 0; n < 2; ++n) _Pragma("unroll") for (int k = 0; k < 2; ++k) dst[n][k] = *(const LAS bf16x8*)(lds + PG8_SB(b, h) + boff + n * 2048 + k * 1024); } while (0)
#define PG8_MMA(ai, bj, At, Bt) do { __builtin_amdgcn_s_setprio(1); _Pragma("unroll") for (int m = 0; m < 4; ++m) _Pragma("unroll") for (int n = 0; n < 2; ++n) _Pragma("unroll") for (int k = 0; k < 2; ++k) \
        acc[ai][bj][m][n] = __builtin_amdgcn_mfma_f32_16x16x32_bf16(Bt[n][k], At[m][k], acc[ai][bj][m][n], 0, 0, 0); __builtin_amdgcn_s_setprio(0); } while (0)
#define PG8_WAIT_V(n) asm volatile("s_waitcnt vmcnt(" #n ")" ::: "memory")
#define PG8_WAIT_L(n) asm volatile("s_waitcnt lgkmcnt(" #n ")" ::: "memory")
#define PG8_BAR __builtin_amdgcn_s_barrier()
#define PG8_SCHED __builtin_amdgcn_sched_barrier(0)
#define PG8_UA(u) ((const char*)g.A + (size_t)(u).pm * tstep + (size_t)(u).seg * sstep)
#define PG8_UB(u) ((const char*)g.Bt + (size_t)(u).pn * tstep + (size_t)(u).seg * sstep)
    Unit cur, nxt; int ui = 0;
    if (!S.next(0, cur)) return;
    f32x4 acc[2][2][4][2];
#pragma unroll
    for (int a = 0; a < 2; ++a)
#pragma unroll
        for (int b = 0; b < 2; ++b)
#pragma unroll
            for (int m = 0; m < 4; ++m)
#pragma unroll
                for (int n = 0; n < 2; ++n) acc[a][b][m][n] = (f32x4){0.f, 0.f, 0.f, 0.f};
    bf16x8 At[4][2], B0[2][2], B1[2][2];
    const char* cA = PG8_UA(cur); const char* cB = PG8_UB(cur);
    PG8_STAGE(PG8_SB(0, 0), cB, voffB); PG8_STAGE(PG8_SB(0, 1), cB + hstep, voffB); PG8_STAGE(PG8_SA(0, 0), cA, voffA); PG8_STAGE(PG8_SA(0, 1), cA + hstep, voffA);
    if (wr == 1) PG8_BAR;
    PG8_WAIT_V(2); PG8_BAR;
    PG8_STAGE(PG8_SB(1, 0), cB + kstep, voffB); PG8_STAGE(PG8_SA(1, 0), cA + kstep, voffA); PG8_STAGE(PG8_SB(1, 1), cB + hstep + kstep, voffB);
    PG8_WAIT_V(6); PG8_BAR;
    for (;;) {
        const bool has_next = S.next(ui + 1, nxt);
        const char* nA = has_next ? PG8_UA(nxt) : cA; const char* nB = has_next ? PG8_UB(nxt) : cB;
        for (int t = 0; t < nt; t += 2) {
            const bool last = (t == nt - 2);
            const char* a1 = cA + (size_t)(t + 1) * kstep;
            const char* a2 = last ? nA : cA + (size_t)(t + 2) * kstep; const char* b2 = last ? nB : cB + (size_t)(t + 2) * kstep;
            const char* a3 = a2 + kstep; const char* b3 = b2 + kstep;
            PG8_LDB(B0, 0, 0); PG8_LDB(B1, 0, 1); PG8_SCHED; PG8_LDA(At, 0, 0); PG8_STAGE(PG8_SA(1, 1), a1 + hstep, voffA);
            PG8_WAIT_V(8); PG8_WAIT_L(0); PG8_BAR; PG8_MMA(0, 0, At, B0); PG8_MMA(0, 1, At, B1); PG8_BAR; PG8_SCHED;
            PG8_LDA(At, 0, 1); PG8_STAGE(PG8_SB(0, 0), b2, voffB); PG8_STAGE(PG8_SB(0, 1), b2 + hstep, voffB); PG8_STAGE(PG8_SA(0, 0), a2, voffA);
            PG8_WAIT_V(8); PG8_WAIT_L(0); PG8_BAR; PG8_MMA(1, 0, At, B0); PG8_MMA(1, 1, At, B1); PG8_BAR; PG8_SCHED;
            PG8_LDB(B0, 1, 0); PG8_LDB(B1, 1, 1); PG8_SCHED; PG8_LDA(At, 1, 0); PG8_STAGE(PG8_SA(0, 1), a2 + hstep, voffA);
            PG8_WAIT_V(8); PG8_WAIT_L(0); PG8_BAR; PG8_MMA(0, 0, At, B0); PG8_MMA(0, 1, At, B1); PG8_BAR; PG8_SCHED;
            PG8_LDA(At, 1, 1); PG8_STAGE(PG8_SB(1, 0), b3, voffB); PG8_STAGE(PG8_SB(1, 1), b3 + hstep, voffB); PG8_STAGE(PG8_SA(1, 0), a3, voffA);
            PG8_WAIT_V(8); PG8_WAIT_L(0); PG8_BAR; PG8_MMA(1, 0, At, B0); PG8_MMA(1, 1, At, B1); PG8_BAR; PG8_SCHED;
        }
        if (wr == 0) PG8_BAR;
        E(acc, cur, wr, wc, fr, fq);
        if (!has_next) break;
        if (E.zero_after(cur)) {
#pragma unroll
            for (int a = 0; a < 2; ++a)
#pragma unroll
                for (int b = 0; b < 2; ++b)
#pragma unroll
                    for (int m = 0; m < 4; ++m)
#pragma unroll
                        for (int n = 0; n < 2; ++n) acc[a][b][m][n] = (f32x4){0.f, 0.f, 0.f, 0.f};
        }
        cur = nxt; cA = nA; cB = nB; ++ui;
        if (wr == 1) PG8_BAR;
    }
    PG8_WAIT_V(0);
    PG8_BAR;
#undef PG8_SA
#undef PG8_SB
#undef PG8_STAGE
#undef PG8_LDA
#undef PG8_LDB
#undef PG8_MMA
#undef PG8_WAIT_V
#undef PG8_WAIT_L
#undef PG8_BAR
#undef PG8_SCHED
#undef PG8_UA
#undef PG8_UB
}
}

namespace att {
constexpr int D = 128, NW = 8, QBLK = 32, KVBLK = 64;
constexpr float SCALE = 0.088388347648318440f;
constexpr float THR = 8.f;
constexpr int SDEPTH = 2;
constexpr size_t SHM_V = KVBLK * D * 2, SHM_K = KVBLK * D * 2, SHM_ATTN = 2 * SHM_V + 2 * SHM_K + NW * 64 * 4;
constexpr float NEGBIG = -1e30f, MFLOOR = -30000.f;
#define KSWZ(row, colB) ((row) * 256 + ((colB) ^ (((row) & 7) << 4)))
#define SBAR() __builtin_amdgcn_sched_barrier(0)
__device__ __forceinline__ int sr_f(int tid) { return tid >> 4; }
__device__ __forceinline__ int crow(int r, int hi) { return (r & 3) + 8 * (r >> 2) + 4 * hi; }
__device__ __forceinline__ unsigned cvtpk(float lo, float hi) { unsigned r; asm volatile("v_cvt_pk_bf16_f32 %0, %1, %2" : "=v"(r) : "v"(lo), "v"(hi)); return r; }

__device__ __forceinline__ void partialSM(f32x16& p0, f32x16& p1, float& m_reg, float& mn, float& alpha) {
  constexpr float C = SCALE * 1.4426950408889634f;
  float pmax = p0[0]; for (int r = 1; r < 16; ++r) pmax = fmaxf(pmax, p0[r]); for (int r = 0; r < 16; ++r) pmax = fmaxf(pmax, p1[r]);
  { auto rr = __builtin_amdgcn_permlane32_swap(__float_as_uint(pmax), __float_as_uint(pmax), false, false);
    pmax = fmaxf(__uint_as_float(rr[0]), __uint_as_float(rr[1])); }
  if (__builtin_expect(__all(pmax - m_reg <= THR / SCALE), 1)) { mn = m_reg; alpha = 1.f; }
  else { mn = fmaxf(m_reg, pmax); alpha = __builtin_amdgcn_exp2f((m_reg - mn) * C); m_reg = mn; }
  float mnC = -mn * C;
  for (int r = 0; r < 16; ++r) p0[r] = fmaf(p0[r], C, mnC); for (int r = 0; r < 16; ++r) p1[r] = fmaf(p1[r], C, mnC);
  for (int r = 0; r < 16; ++r) p0[r] = __builtin_amdgcn_exp2f(p0[r]);
}
__device__ __forceinline__ void finishSM(f32x16& p0, f32x16& p1, float alpha, float& l_reg, bf16x8& pa0, bf16x8& pa1, bf16x8& pa2, bf16x8& pa3) {
  for (int r = 0; r < 16; ++r) p1[r] = __builtin_amdgcn_exp2f(p1[r]);
  float ps = 0; for (int r = 0; r < 16; ++r) ps += p0[r]; for (int r = 0; r < 16; ++r) ps += p1[r];
  { auto rr = __builtin_amdgcn_permlane32_swap(__float_as_uint(ps), __float_as_uint(ps), false, false);
    ps = __uint_as_float(rr[0]) + __uint_as_float(rr[1]); }
  l_reg = l_reg * alpha + ps;
#define PK4(P, BASE, OUT) do { unsigned a0 = cvtpk(P[BASE + 0], P[BASE + 1]), a1 = cvtpk(P[BASE + 2], P[BASE + 3]);   \
    unsigned b0 = cvtpk(P[BASE + 4], P[BASE + 5]), b1 = cvtpk(P[BASE + 6], P[BASE + 7]);                              \
    auto r0 = __builtin_amdgcn_permlane32_swap(a0, b0, false, false); auto r1 = __builtin_amdgcn_permlane32_swap(a1, b1, false, false); \
    u32x4 w = {r0[0], r1[0], r0[1], r1[1]}; OUT = *reinterpret_cast<bf16x8*>(&w); } while (0)
  PK4(p0, 0, pa0); PK4(p0, 8, pa1); PK4(p1, 0, pa2); PK4(p1, 8, pa3);
#undef PK4
}
__device__ __forceinline__ void qkt(f32x16& p0, f32x16& p1, const LAS char* Ks, const bf16x8* qr, int r32, int hi) {
  p0 = f32x16{}; p1 = f32x16{};
  for (int d0 = 0; d0 < 8; ++d0) { int cb = (d0 * 16 + hi * 8) * 2;
    bf16x8 b0 = *reinterpret_cast<const LAS bf16x8*>(Ks + KSWZ(r32, cb));
    bf16x8 b1 = *reinterpret_cast<const LAS bf16x8*>(Ks + KSWZ(32 + r32, cb));
    p0 = __builtin_amdgcn_mfma_f32_32x32x16_bf16(b0, qr[d0], p0, 0, 0, 0);
    p1 = __builtin_amdgcn_mfma_f32_32x32x16_bf16(b1, qr[d0], p1, 0, 0, 0); }
}
__device__ __forceinline__ int v_st(int k, int c) { const int kk = (k & ~0xC) | ((k & 4) << 1) | ((k & 8) >> 1); return ((kk >> 3) * 4 + (c >> 5)) * 512 + ((kk & 7) * 32 + (c & 31)) * 2; }
__device__ __forceinline__ int v_rd_base(int lane) { return ((lane & 3) << 3) | (((lane >> 2) & 3) << 6) | (((lane >> 4) & 1) << 5) | (((lane >> 5) & 1) << 8); }
constexpr int v_rd_off(int d0, int ks, int half) { return d0 * 512 + ks * 4096 + half * 2048; }
template <int OFF> __device__ __forceinline__ s16x4 tr_read(int vb) {
  s16x4 r; asm volatile("ds_read_b64_tr_b16 %0, %1 offset:%2" : "=&v"(r) : "v"(vb), "i"(OFF) : "memory"); return r;
}
template <int D0> __device__ __forceinline__ void pv_one(f32x16& od, int vb, bf16x8 pa0, bf16x8 pa1, bf16x8 pa2, bf16x8 pa3) {
  const s16x4 l0 = tr_read<v_rd_off(D0, 0, 0)>(vb), h0 = tr_read<v_rd_off(D0, 0, 1)>(vb), l1 = tr_read<v_rd_off(D0, 1, 0)>(vb), h1 = tr_read<v_rd_off(D0, 1, 1)>(vb);
  const s16x4 l2 = tr_read<v_rd_off(D0, 2, 0)>(vb), h2 = tr_read<v_rd_off(D0, 2, 1)>(vb), l3 = tr_read<v_rd_off(D0, 3, 0)>(vb), h3 = tr_read<v_rd_off(D0, 3, 1)>(vb);
  asm volatile("s_waitcnt lgkmcnt(0)" ::: "memory"); SBAR();
#define PK(L, H) (bf16x8){L[0], L[1], L[2], L[3], H[0], H[1], H[2], H[3]}
  od = __builtin_amdgcn_mfma_f32_32x32x16_bf16(pa0, PK(l0, h0), od, 0, 0, 0);
  od = __builtin_amdgcn_mfma_f32_32x32x16_bf16(pa1, PK(l1, h1), od, 0, 0, 0);
  od = __builtin_amdgcn_mfma_f32_32x32x16_bf16(pa2, PK(l2, h2), od, 0, 0, 0);
  od = __builtin_amdgcn_mfma_f32_32x32x16_bf16(pa3, PK(l3, h3), od, 0, 0, 0);
#undef PK
}
__device__ __forceinline__ void pv_d0(f32x16* o, int vb, bf16x8 pa0, bf16x8 pa1, bf16x8 pa2, bf16x8 pa3) {
  pv_one<0>(o[0], vb, pa0, pa1, pa2, pa3); pv_one<1>(o[1], vb, pa0, pa1, pa2, pa3); pv_one<2>(o[2], vb, pa0, pa1, pa2, pa3); pv_one<3>(o[3], vb, pa0, pa1, pa2, pa3);
}

struct MaskNone { static constexpr bool ANY = false; __device__ __forceinline__ void apply(f32x16&, f32x16&, int, int, int, int) const {} };
struct MaskBand {
  static constexpr bool ANY = true; int d0, reach;
  __device__ __forceinline__ void apply(f32x16& p0, f32x16& p1, int tile, int wid, int r32, int hi) const {
    const int base = d0 + tile * 64 - (wid * 32 + r32) + 4 * hi + reach; const unsigned lim = 2u * (unsigned)reach;
#pragma unroll
    for (int r = 0; r < 16; ++r) { const int k = (r & 3) + 8 * (r >> 2);
      if ((unsigned)(base + k) > lim) p0[r] = NEGBIG;
      if ((unsigned)(base + k + 32) > lim) p1[r] = NEGBIG; }
  }
};
struct MaskNA {
  static constexpr bool ANY = true; int qrow0, krow0; const LAS float* tab;
  __device__ __forceinline__ void apply(f32x16& p0, f32x16& p1, int tile, int wid, int r32, int hi) const {
    const int qr = qrow0 + (wid >> 1), kr = krow0 + tile; int rs = qr - 4; rs = rs < 0 ? 0 : (rs > 120 ? 120 : rs);
    if (kr < rs || kr >= rs + 8) {
#pragma unroll
      for (int r = 0; r < 16; ++r) { p0[r] = NEGBIG; p1[r] = NEGBIG; }
    } else {
      const int qc = (wid & 1) * 32 + r32; int cs = qc - 8; cs = cs < 0 ? 0 : (cs > 48 ? 48 : cs);
      const LAS float* trow = tab + (kr - qr + 7) * 128 + 63 - qc + 4 * hi;
      const int cb = 4 * hi - cs;
#pragma unroll
      for (int r = 0; r < 16; ++r) { const int k = (r & 3) + 8 * (r >> 2);
        p0[r] = ((unsigned)(cb + k) < 16u) ? p0[r] + trow[k] : NEGBIG;
        p1[r] = ((unsigned)(cb + k + 32) < 16u) ? p1[r] + trow[k + 32] : NEGBIG; }
    }
  }
};
struct OutGated {
  bf16_t* y; const bf16_t* gate;
  __device__ __forceinline__ void store4(int row, int col, f32x4 v) const {
    const u32x2 g = *(const u32x2*)((const char*)gate + (unsigned)(row * INC + col) * 2u);
    u32x2 w; w.x = cvt_pk_bf16(v.x * bf_lo(g.x), v.y * bf_hi(g.x)); w.y = cvt_pk_bf16(v.z * bf_lo(g.y), v.w * bf_hi(g.y));
    *(u32x2*)((char*)y + (unsigned)(row * DM + col) * 2u) = w; }
  __device__ __forceinline__ void lse(int, float, float) const {}
};
struct OutPartial {
  bf16_t* po; float* plse; int dil;
  __device__ __forceinline__ void store4(int row, int col, f32x4 v) const {
    u32x2 w; w.x = cvt_pk_bf16(v.x, v.y); w.y = cvt_pk_bf16(v.z, v.w);
    *(u32x2*)((char*)po + (unsigned)(row * dil * 512 + col) * 2u) = w; }
  __device__ __forceinline__ void lse(int row, float m, float l) const { plse[(unsigned)(row * dil * 4)] = m * SCALE + __logf(l); }
};
constexpr int TAB_OFF = 67584, STG_OFF = 75776, STG_STRIDE = 68, STG_WAVE = 32 * STG_STRIDE * 4;

template <class Mask, class Out, int SD = 2>
__device__ __forceinline__ void attn_unit(const bf16_t* __restrict__ Qb, const bf16_t* __restrict__ Kh, const bf16_t* __restrict__ Vh, const int ldq, const int ldk,
                                          const int NT, const float m_init, const float l_init, const Mask& mask, const Out& out, LAS char* lds) {
  int tid = threadIdx.x; asm volatile("" : "+v"(tid));
  const int wid = __builtin_amdgcn_readfirstlane(tid >> 6), lane = tid & 63, r32 = lane & 31, hi = lane >> 5;
  LAS char* V_lds = lds; LAS char* K_lds = lds + 2 * SHM_V;
  LAS float* ws = (LAS float*)(lds + 2 * SHM_V + 2 * SHM_K) + wid * 64; LAS float* li_l = ws; LAS float* al_l = ws + 32;
  float m_reg = m_init, l_reg = l_init; f32x16 o[4] = {}; bf16x8 qr[8];
  { const unsigned qoff = (unsigned)((wid * QBLK + r32) * ldq + hi * 8) * 2u;
#pragma unroll
    for (int d0 = 0; d0 < 8; ++d0) qr[d0] = *reinterpret_cast<const bf16x8*>((const char*)Qb + qoff + d0 * 32); }
  const unsigned kvoff = (unsigned)(sr_f(tid) * ldk + (tid & 15) * 8) * 2u; const size_t tileb = (size_t)ldk * 2, half32 = tileb * 32;
  const int sr = tid >> 4, sc = (tid & 15) * 8, vst0 = v_st(sr, sc), vst1 = v_st(32 + sr, sc);
  const int vb0 = (int)(uintptr_t)V_lds + v_rd_base(lane);
  struct { bf16x8 vs0, vs1, ks0, ks1; } sr_[SD];
#define SLOAD(i, k0) do { const char* vp_ = (const char*)Vh + (size_t)(k0) * tileb; const char* kp_ = (const char*)Kh + (size_t)(k0) * tileb; \
    sr_[i].vs0 = *reinterpret_cast<const bf16x8*>(vp_ + kvoff); sr_[i].vs1 = *reinterpret_cast<const bf16x8*>(vp_ + half32 + kvoff); \
    sr_[i].ks0 = *reinterpret_cast<const bf16x8*>(kp_ + kvoff); sr_[i].ks1 = *reinterpret_cast<const bf16x8*>(kp_ + half32 + kvoff); } while (0)
#define SWRITE(b, i) do { *(LAS bf16x8*)(V_lds + (b) * SHM_V + vst0) = sr_[i].vs0;          \
    *(LAS bf16x8*)(V_lds + (b) * SHM_V + vst1) = sr_[i].vs1; int kc = sc * 2;               \
    *(LAS bf16x8*)(K_lds + (b) * SHM_K + KSWZ(sr, kc)) = sr_[i].ks0;                       \
    *(LAS bf16x8*)(K_lds + (b) * SHM_K + KSWZ(32 + sr, kc)) = sr_[i].ks1; } while (0)
#define SWAIT() do { if constexpr (SD == 2) asm volatile("s_waitcnt vmcnt(4)" ::: "memory"); else asm volatile("s_waitcnt vmcnt(0)" ::: "memory"); } while (0)
#define RESC(a) do { if (__any((a) < 1.f)) { if (hi == 0) al_l[r32] = (a); asm volatile("s_waitcnt lgkmcnt(0)" ::: "memory"); \
    for (int d = 0; d < 4; ++d) for (int r = 0; r < 16; ++r) o[d][r] *= al_l[crow(r, hi)]; } } while (0)
  f32x16 pA0, pA1, pB0, pB1; float mnA, mnB, alA, alB; bf16x8 pa0, pa1, pa2, pa3;
  constexpr int SE = 0, SO = SD - 1;
  SLOAD(SE, 0); asm volatile("s_waitcnt vmcnt(0)" ::: "memory"); SWRITE(0, SE); __syncthreads();
  qkt(pA0, pA1, K_lds, qr, r32, hi); mask.apply(pA0, pA1, 0, wid, r32, hi); partialSM(pA0, pA1, m_reg, mnA, alA);
  SLOAD(SO, KVBLK); if constexpr (SD == 2) { if (2 < NT) SLOAD(SE, 2 * KVBLK); }
  SWAIT(); SWRITE(1, SO); __syncthreads();
  for (int j = 1; j + 1 < NT; j += 2) {
    SBAR(); qkt(pB0, pB1, K_lds + SHM_K, qr, r32, hi);
    finishSM(pA0, pA1, alA, l_reg, pa0, pa1, pa2, pa3); SBAR();
    SLOAD(SO, (j + SD) * KVBLK); SBAR();
    pv_d0(o, vb0, pa0, pa1, pa2, pa3); mask.apply(pB0, pB1, j, wid, r32, hi); partialSM(pB0, pB1, m_reg, mnB, alB);
    __syncthreads(); SWAIT(); SWRITE(0, SE);
    RESC(alB); __syncthreads();
    SBAR(); qkt(pA0, pA1, K_lds, qr, r32, hi);
    finishSM(pB0, pB1, alB, l_reg, pa0, pa1, pa2, pa3); SBAR();
    if (SD == 1 || j + 3 < NT) SLOAD(SE, (j + 1 + SD) * KVBLK); SBAR();
    pv_d0(o, vb0 + (int)SHM_V, pa0, pa1, pa2, pa3); mask.apply(pA0, pA1, j + 1, wid, r32, hi); partialSM(pA0, pA1, m_reg, mnA, alA);
    __syncthreads(); SWAIT(); SWRITE(1, SO);
    RESC(alA); __syncthreads();
  }
  SBAR(); qkt(pB0, pB1, K_lds + SHM_K, qr, r32, hi);
  finishSM(pA0, pA1, alA, l_reg, pa0, pa1, pa2, pa3); SBAR();
  pv_d0(o, vb0, pa0, pa1, pa2, pa3); mask.apply(pB0, pB1, NT - 1, wid, r32, hi); partialSM(pB0, pB1, m_reg, mnB, alB);
  __syncthreads(); RESC(alB);
  finishSM(pB0, pB1, alB, l_reg, pa0, pa1, pa2, pa3); SBAR();
  pv_d0(o, vb0 + (int)SHM_V, pa0, pa1, pa2, pa3);
  if (hi == 0) { li_l[r32] = l_reg; out.lse(wid * QBLK + r32, m_reg, l_reg); } asm volatile("s_waitcnt lgkmcnt(0)" ::: "memory");
  float rli[16];
#pragma unroll
  for (int r = 0; r < 16; ++r) rli[r] = __builtin_amdgcn_rcpf(li_l[crow(r, hi)]);
  LAS float* stg = (LAS float*)(lds + STG_OFF + wid * STG_WAVE);
#pragma unroll
  for (int half = 0; half < 2; ++half) {
#pragma unroll
    for (int r = 0; r < 16; ++r) {
      stg[crow(r, hi) * STG_STRIDE + r32] = o[half * 2][r] * rli[r]; stg[crow(r, hi) * STG_STRIDE + 32 + r32] = o[half * 2 + 1][r] * rli[r]; }
    asm volatile("s_waitcnt lgkmcnt(0)" ::: "memory");
#pragma unroll
    for (int i = 0; i < 8; ++i) { const int row = i * 4 + (lane >> 4), c4 = (lane & 15) * 4;
      const f32x4 v = *(const LAS f32x4*)(stg + row * STG_STRIDE + c4);
      out.store4(wid * QBLK + row, half * 64 + c4, v); }
    asm volatile("s_waitcnt lgkmcnt(0)" ::: "memory");
  }
#undef SLOAD
#undef SWRITE
#undef SWAIT
#undef RESC
}
}

#ifndef PH_A
#define PH_A 1
#endif
#ifndef PH_B
#define PH_B 1
#endif
#ifndef PH_C
#define PH_C 1
#endif
#ifndef PH_D
#define PH_D 1
#endif
#ifndef PH_G1
#define PH_G1 1
#endif
#ifndef PH_G2
#define PH_G2 1
#endif
#ifndef PH_G3
#define PH_G3 1
#endif

struct Params {
  const float *x, *c, *norm_g, *w_ada, *b_ada, *w_in, *a_sink, *c_q_norm, *c_k_norm, *d_rel_bias, *w_gm, *w_branch, *w_out, *final_g;
  float* out; unsigned char* ws;
};
constexpr int LDS_BYTES = 147456;

__device__ __forceinline__ float wave_sum(float v) {
#pragma unroll
  for (int o = 1; o < 64; o <<= 1) v += __shfl_xor(v, o);
  return v;
}
__device__ __forceinline__ void transpose_item(const float* __restrict__ W, int N, bf16_t* __restrict__ WT, int dpitch, int row_off, int coff, LAS float* scr, int item, int lane) {
  const int nblk = N / 32, kb = item / nblk, nb = item % nblk, k0 = 64 * kb, n0 = 32 * nb;
#pragma unroll 8
  for (int i = 0; i < 32; ++i) { const int kk = 2 * i + (lane >> 5); scr[kk * 33 + (lane & 31)] = W[(size_t)(k0 + kk) * N + n0 + (lane & 31)]; }
  asm volatile("s_waitcnt lgkmcnt(0)" ::: "memory");
  const int c = lane & 7;
#pragma unroll
  for (int j = 0; j < 4; ++j) { const int n = (lane >> 3) + 8 * j; const LAS float* s = scr + (8 * c) * 33 + n;
    u32x4 o; o.x = cvt_pk_bf16(s[0 * 33], s[1 * 33]); o.y = cvt_pk_bf16(s[2 * 33], s[3 * 33]); o.z = cvt_pk_bf16(s[4 * 33], s[5 * 33]); o.w = cvt_pk_bf16(s[6 * 33], s[7 * 33]);
    *(u32x4*)(WT + (size_t)(row_off + n0 + n) * dpitch + coff + k0 + 8 * c) = o; }
  asm volatile("s_waitcnt lgkmcnt(0)" ::: "memory");
}

__global__ void __launch_bounds__(512) mega_fwd(Params p) {
  extern __shared__ __attribute__((aligned(16))) unsigned char lds_raw[];
  LAS unsigned char* lds = (LAS unsigned char*)lds_raw;
  cg::grid_group grid = cg::this_grid();
  const int G = gridDim.x, cb = blockIdx.x, NGW = G * 8;
#define PHASE_IDS int tid = threadIdx.x; asm volatile("" : "+v"(tid)); const int lane = tid & 63, wave = __builtin_amdgcn_readfirstlane(tid >> 6), gw = cb * 8 + wave; (void)lane; (void)gw;
  unsigned char* ws = p.ws;
  bf16_t* WT1 = (bf16_t*)(ws + WS_WT1); bf16_t* WT2 = (bf16_t*)(ws + WS_WT2); bf16_t* WT3 = (bf16_t*)(ws + WS_WT3);
  bf16_t* HB = (bf16_t*)(ws + WS_H); bf16_t* YB = HB; bf16_t* QKVG = (bf16_t*)(ws + WS_QKVG); bf16_t* MERGED = QKVG; bf16_t* MG = (bf16_t*)(ws + WS_MG);
  bf16_t* PO = (bf16_t*)(ws + WS_PO); float* PLSE = (float*)(ws + WS_PLSE); float* ADA = (float*)(ws + WS_ADA);

  {
    PHASE_IDS
    LAS float* sc = (LAS float*)lds; LAS float* red = (LAS float*)(lds + 16384);
    for (int i = tid; i < NB * DM; i += 512) { const float v = p.c[i]; sc[i] = v * sigmoidf_(v); }
    __syncthreads();
    for (int u = cb; u < DEPTH * 96; u += G) {
      const int l = u / 96, jb = u % 96, col = jb * 64 + lane;
      const float* W = p.w_ada + (size_t)l * DM * (3 * DM) + col;
      float a0 = 0.f, a1 = 0.f; const int k0 = wave * 256;
#pragma unroll 8
      for (int k = 0; k < 256; ++k) { const float w = W[(size_t)(k0 + k) * (3 * DM)]; a0 += sc[k0 + k] * w; a1 += sc[DM + k0 + k] * w; }
      red[(wave * 2 + 0) * 64 + lane] = a0; red[(wave * 2 + 1) * 64 + lane] = a1;
      __syncthreads();
      if (tid < 128) { const int b = tid >> 6, cc = tid & 63; float s = 0.f;
#pragma unroll
        for (int w = 0; w < 8; ++w) s += red[(w * 2 + b) * 64 + cc];
        ADA[(size_t)(l * NB + b) * (3 * DM) + jb * 64 + cc] = s + p.b_ada[l * 3 * DM + jb * 64 + cc]; }
      __syncthreads();
    }
    __syncthreads();
    LAS float* scr = (LAS float*)(lds + wave * 16384);
    constexpr int I_IN = 32 * (INC / 32), I_GM = 32 * (GMC / 32), I_BR = 4 * 8 * 64, I_OUT = 32 * 64, I_L = I_IN + I_GM + I_BR + I_OUT;
    for (int it = gw; it < DEPTH * I_L; it += NGW) {
      const int l = it / I_L; int r = it % I_L;
      if (r < I_IN) { transpose_item(p.w_in + (size_t)l * DM * INC, INC, WT1 + (size_t)l * N1 * DM, DM, 0, 0, scr, r, lane); continue; } r -= I_IN;
      if (r < I_GM) { transpose_item(p.w_gm + (size_t)l * DM * GMC, GMC, WT1 + (size_t)l * N1 * DM, DM, INC, 0, scr, r, lane); continue; } r -= I_GM;
      if (r < I_BR) { const int n = r / 512; transpose_item(p.w_branch + (size_t)(l * 4 + n) * 512 * DM, DM, WT2 + (size_t)l * DM * DM, DM, 0, n * 512, scr, r % 512, lane); continue; } r -= I_BR;
      transpose_item(p.w_out + (size_t)l * DM * DM, DM, WT3 + (size_t)l * DM * DM, DM, 0, 0, scr, r, lane);
    }
  }
  grid.sync();

#pragma unroll 1
  for (int l = 0; l < DEPTH; ++l) {
    const float* xin = (l == 0) ? p.x : p.out;
    { PHASE_IDS
    for (int row = gw; row < NTOK; row += NGW) {
      const int b = row >> 13;
      const f32x4* xr = (const f32x4*)(xin + (size_t)row * DM) + lane;
      f32x4 v[8]; float ss = 0.f;
#pragma unroll
      for (int j = 0; j < 8; ++j) { v[j] = xr[64 * j]; ss += (v[j].x * v[j].x + v[j].y * v[j].y) + (v[j].z * v[j].z + v[j].w * v[j].w); }
      const float rstd = rsqrtf(wave_sum(ss) * (1.f / DM) + EPS);
      const float* ad = ADA + (size_t)(l * NB + b) * (3 * DM);
      u32x2* o8 = (u32x2*)(HB + (size_t)row * DM) + lane;
#pragma unroll
      for (int j = 0; j < 8; ++j) { const int col = (64 * j + lane) * 4;
        const f32x4 g = *(const f32x4*)(p.norm_g + l * DM + col), sh = *(const f32x4*)(ad + col), scl = *(const f32x4*)(ad + DM + col);
        const f32x4 y = (v[j] * rstd * g) * (scl + 1.0f) + sh;
        u32x2 w; w.x = cvt_pk_bf16(y.x, y.y); w.y = cvt_pk_bf16(y.z, y.w); o8[64 * j] = w; }
    } }
    grid.sync();
#if PH_G1
    { pg8::Gemm g{HB, WT1 + (size_t)l * N1 * DM, DM, DM}; pg8::Order S; S.init(NTOK, N1, G, cb, 0);
      pg8::EpiG1 E{QKVG, MG}; pg8::gemm_phase<pg8::EpiG1>(lds, g, S, E); }
#endif
    grid.sync();
    { PHASE_IDS
    for (int it = gw; it < NTOK * 5; it += NGW) {
      const int tok = it / 5, w5 = it % 5, s = tok & (SEQ - 1), l16 = lane & 15, hd = w5 * 4 + (lane >> 4);
      int col, type;
      if (hd < 4) { col = QA + hd * 128; type = 0; } else if (hd < 6) { col = KA + (hd - 4) * 128; type = 0; } else if (hd < 10) { col = QB_ + (hd - 6) * 128; type = 0; }
      else if (hd < 14) { col = KB_ + (hd - 10) * 128; type = 0; } else if (hd < 18) { col = QC + (hd - 14) * 128; type = 1; } else { col = KC + (hd - 18) * 128; type = 2; }
      bf16_t* base = QKVG + (size_t)tok * INC + col;
      int e0, dist; float pos; const float* inv;
      if (type == 0) { e0 = 4 * l16; dist = 64; pos = (float)s; inv = INV64 + e0; }
      else { if (l16 < 8) { e0 = 4 * l16; pos = (float)(s >> 6); inv = INV32 + e0; } else { e0 = 64 + 4 * (l16 - 8); pos = (float)(s & 63); inv = INV32 + (e0 - 64); } dist = 32; }
      const u32x2 ra = *(const u32x2*)(base + e0), rb = *(const u32x2*)(base + e0 + dist);
      float a[4] = {bf_lo(ra.x), bf_hi(ra.x), bf_lo(ra.y), bf_hi(ra.y)}, b[4] = {bf_lo(rb.x), bf_hi(rb.x), bf_lo(rb.y), bf_hi(rb.y)};
      float ss = (a[0] * a[0] + a[1] * a[1]) + (a[2] * a[2] + a[3] * a[3]) + (b[0] * b[0] + b[1] * b[1]) + (b[2] * b[2] + b[3] * b[3]);
      ss += __shfl_xor(ss, 1); ss += __shfl_xor(ss, 2); ss += __shfl_xor(ss, 4); ss += __shfl_xor(ss, 8);
      if (type != 0) { const float rstd = rsqrtf(ss * (1.f / 128.f) + EPS); const float* wn = (type == 1 ? p.c_q_norm : p.c_k_norm) + l * 128;
#pragma unroll
        for (int j = 0; j < 4; ++j) { a[j] = a[j] * rstd * wn[e0 + j]; b[j] = b[j] * rstd * wn[e0 + dist + j]; } }
      float oa[4], ob[4];
#pragma unroll
      for (int j = 0; j < 4; ++j) { const float ang = pos * inv[j]; double rev = (double)ang * 0.15915494309189535; rev -= __builtin_rint(rev);
        const float fr = (float)rev, sn = __builtin_amdgcn_sinf(fr), cs = __builtin_amdgcn_cosf(fr);
        oa[j] = a[j] * cs - b[j] * sn; ob[j] = b[j] * cs + a[j] * sn; }
      u32x2 wa, wb; wa.x = cvt_pk_bf16(oa[0], oa[1]); wa.y = cvt_pk_bf16(oa[2], oa[3]); wb.x = cvt_pk_bf16(ob[0], ob[1]); wb.y = cvt_pk_bf16(ob[2], ob[3]);
      *(u32x2*)(base + e0) = wa; *(u32x2*)(base + e0 + dist) = wb;
    } }
    grid.sync();
    { PHASE_IDS
    for (int u = cb; u < 1280; u += G) {
#if PH_A
      if (u < 256) {
        const int b = u >> 7, hq = (u >> 5) & 3, qb = u & 31, q0 = qb * 256;
        int lo = q0 - 128; if (lo < 0) lo = 0; int hi = q0 + 384; if (hi > SEQ) hi = SEQ;
        const size_t t0 = (size_t)b * SEQ + q0, k0 = (size_t)b * SEQ + lo;
        att::MaskBand mk{lo - q0, 128}; att::OutGated og{YB + t0 * DM + 0 * 512 + hq * 128, QKVG + t0 * INC + GA + hq * 128};
        att::attn_unit(QKVG + t0 * INC + QA + hq * 128, QKVG + k0 * INC + KA + (hq >> 1) * 128, QKVG + k0 * INC + VA + (hq >> 1) * 128, INC, INC, (hi - lo) >> 6,
                       p.a_sink[l * 4 + hq] * (1.0f / att::SCALE), 1.0f, mk, og, (LAS char*)lds);
      } else
#endif
#if PH_B
      if (u >= 256 && u < 1024) {
        const int v = u - 256, pt = v >> 8, b = (v >> 7) & 1, h = (v >> 5) & 3, blk = v & 31;
        const int dsh = 2 * pt, dil = 1 << dsh, L = SEQ >> dsh, bpr = L >> 8;
        const int r = blk / bpr, lb = blk % bpr, l0 = lb * 256;
        int lo = l0 - 64; if (lo < 0) lo = 0; int hi = l0 + 320; if (hi > L) hi = L;
        if (((hi - lo) >> 6) & 1) { if (lo == 0) hi += 64; else lo -= 64; }
        const size_t t0 = (size_t)b * SEQ + r + (size_t)dil * l0, k0 = (size_t)b * SEQ + r + (size_t)dil * lo;
        att::MaskBand mk{lo - l0, 64}; att::OutPartial op{PO + ((size_t)pt * NTOK + t0) * 512 + h * 128, PLSE + ((size_t)pt * NTOK + t0) * 4 + h, dil};
        att::attn_unit(QKVG + t0 * INC + QB_ + h * 128, QKVG + k0 * INC + KB_ + h * 128, QKVG + k0 * INC + VB_ + h * 128, INC * dil, INC * dil, (hi - lo) >> 6,
                       att::MFLOOR, 0.0f, mk, op, (LAS char*)lds);
      } else
#endif
#if PH_D
      if (u >= 1024) {
        const int v = u - 1024, b = v >> 7, h = (v >> 5) & 3, blk = v & 31, r0 = blk * 4;
        int lo = r0 - 4; lo = lo < 0 ? 0 : (lo > 120 ? 120 : lo); int hi = r0 + 3 - 4; hi = (hi < 0 ? 0 : (hi > 120 ? 120 : hi)) + 8;
        if ((hi - lo) & 1) { if (hi < 128) hi += 1; else lo -= 1; }
        LAS float* tab = (LAS float*)(lds + att::TAB_OFF);
        __syncthreads();
        for (int i = tid; i < 15 * 128; i += 512) { const int dr = i >> 7, dc = (i & 127) - 63;
          tab[i] = (dc >= -15 && dc <= 15) ? p.d_rel_bias[(size_t)(l * 4 + h) * 465 + dr * 31 + dc + 15] * (1.0f / att::SCALE) : 0.f; }
        __syncthreads();
        const size_t t0 = (size_t)b * SEQ + r0 * 64, k0 = (size_t)b * SEQ + lo * 64;
        att::MaskNA mk{r0, lo, tab}; att::OutGated og{YB + t0 * DM + 3 * 512 + h * 128, QKVG + t0 * INC + GD + h * 128};
        att::attn_unit<att::MaskNA, att::OutGated, 1>(QKVG + t0 * INC + QD + h * 128, QKVG + k0 * INC + KD + h * 128, QKVG + k0 * INC + VD + h * 128, INC, INC, hi - lo,
                       att::MFLOOR, 0.0f, mk, og, (LAS char*)lds);
      }
#endif
      {}
    } }
    grid.sync();
    { PHASE_IDS
    for (int tok = gw; tok < NTOK; tok += NGW) {
      const int h = lane >> 4, c8 = (lane & 15) * 8;
      const float l0 = PLSE[((size_t)0 * NTOK + tok) * 4 + h], l1 = PLSE[((size_t)1 * NTOK + tok) * 4 + h], l2 = PLSE[((size_t)2 * NTOK + tok) * 4 + h];
      const float mx = fmaxf(l0, fmaxf(l1, l2)); float w0 = __expf(l0 - mx), w1 = __expf(l1 - mx), w2 = __expf(l2 - mx); const float rs = 1.0f / (w0 + w1 + w2); w0 *= rs; w1 *= rs; w2 *= rs;
      const u32x4 o0 = *(const u32x4*)(PO + ((size_t)0 * NTOK + tok) * 512 + h * 128 + c8), o1 = *(const u32x4*)(PO + ((size_t)1 * NTOK + tok) * 512 + h * 128 + c8), o2 = *(const u32x4*)(PO + ((size_t)2 * NTOK + tok) * 512 + h * 128 + c8);
      const u32x4 gg = *(const u32x4*)(QKVG + (size_t)tok * INC + GB_ + h * 128 + c8);
      u32x4 y;
#define CMB(F) cvt_pk_bf16((w0 * bf_lo(o0.F) + w1 * bf_lo(o1.F) + w2 * bf_lo(o2.F)) * bf_lo(gg.F), (w0 * bf_hi(o0.F) + w1 * bf_hi(o1.F) + w2 * bf_hi(o2.F)) * bf_hi(gg.F))
      y.x = CMB(x); y.y = CMB(y); y.z = CMB(z); y.w = CMB(w);
#undef CMB
      *(u32x4*)(YB + (size_t)tok * DM + 1 * 512 + h * 128 + c8) = y;
    } }
#if PH_C
    for (int u = cb; u < 256; u += G) {
      const int xcd = u & 7, idx = u >> 3, pair = xcd >> 1, b = pair >> 1, kvh = pair & 1, hq = kvh * 2 + (xcd & 1), q0 = idx * 256;
      const size_t t0 = (size_t)b * SEQ + q0, k0 = (size_t)b * SEQ;
      att::MaskNone mk; att::OutGated og{YB + t0 * DM + 2 * 512 + hq * 128, QKVG + t0 * INC + GC + hq * 128};
      att::attn_unit(QKVG + t0 * INC + QC + hq * 128, QKVG + k0 * INC + KC + kvh * 128, QKVG + k0 * INC + VC + kvh * 128, INC, INC, SEQ / 64,
                     att::MFLOOR, 0.0f, mk, og, (LAS char*)lds);
    }
#endif
    grid.sync();
#if PH_G2
    { pg8::Gemm g{YB, WT2 + (size_t)l * DM * DM, DM, 512}; pg8::Order S; S.init(NTOK, DM, G, cb, 2);
      pg8::EpiG2 E{MG, MERGED}; pg8::gemm_phase<pg8::EpiG2>(lds, g, S, E); }
#endif
    grid.sync();
#if PH_G3
    { pg8::Gemm g{MERGED, WT3 + (size_t)l * DM * DM, DM, DM}; pg8::Order S; S.init(NTOK, DM, G, cb, 0);
      pg8::EpiG3 E{xin, p.out, ADA + (size_t)(l * NB) * (3 * DM) + 2 * DM}; pg8::gemm_phase<pg8::EpiG3>(lds, g, S, E); }
#endif
    grid.sync();
  }
  { PHASE_IDS
  for (int row = gw; row < NTOK; row += NGW) {
    f32x4* xr = (f32x4*)(p.out + (size_t)row * DM) + lane;
    f32x4 v[8]; float ss = 0.f;
#pragma unroll
    for (int j = 0; j < 8; ++j) { v[j] = xr[64 * j]; ss += (v[j].x * v[j].x + v[j].y * v[j].y) + (v[j].z * v[j].z + v[j].w * v[j].w); }
    const float rstd = rsqrtf(wave_sum(ss) * (1.f / DM) + EPS);
#pragma unroll
    for (int j = 0; j < 8; ++j) { const f32x4 g = *(const f32x4*)(p.final_g + (64 * j + lane) * 4); xr[64 * j] = v[j] * rstd * g; }
  } }
}

extern "C" void kernel_launch(void* const* d_in, const int* in_sizes, int n_in, void* d_out, int out_size, void* d_ws, size_t ws_size, hipStream_t stream) {
  static int grid_blocks = 0;
  if (grid_blocks == 0) {
    if (n_in != 14 || out_size != NTOK * DM || ws_size < WS_END) { fprintf(stderr, "kernel_launch: unexpected shapes (n_in %d out %d ws %zu need %zu)\n", n_in, out_size, ws_size, (size_t)WS_END); grid_blocks = -1; return; }
    int dev = 0, cus = 0, per_cu = 0;
    hipGetDevice(&dev); hipDeviceGetAttribute(&cus, hipDeviceAttributeMultiprocessorCount, dev);
    if (hipFuncSetAttribute((const void*)mega_fwd, hipFuncAttributeMaxDynamicSharedMemorySize, LDS_BYTES) != hipSuccess) { fprintf(stderr, "kernel_launch: hipFuncSetAttribute failed\n"); grid_blocks = -1; return; }
    hipOccupancyMaxActiveBlocksPerMultiprocessor(&per_cu, (const void*)mega_fwd, 512, LDS_BYTES);
    (void)hipGetLastError();
    if (per_cu < 1) per_cu = 1;
    grid_blocks = cus * 1;
  }
  if (grid_blocks < 0) return;
  Params p{};
  p.x = (const float*)d_in[0]; p.c = (const float*)d_in[1]; p.norm_g = (const float*)d_in[2]; p.w_ada = (const float*)d_in[3]; p.b_ada = (const float*)d_in[4];
  p.w_in = (const float*)d_in[5]; p.a_sink = (const float*)d_in[6]; p.c_q_norm = (const float*)d_in[7]; p.c_k_norm = (const float*)d_in[8]; p.d_rel_bias = (const float*)d_in[9];
  p.w_gm = (const float*)d_in[10]; p.w_branch = (const float*)d_in[11]; p.w_out = (const float*)d_in[12]; p.final_g = (const float*)d_in[13];
  p.out = (float*)d_out; p.ws = (unsigned char*)d_ws;
  void* args[] = {&p};
  hipError_t e = hipLaunchCooperativeKernel((const void*)mega_fwd, dim3(grid_blocks), dim3(512), args, LDS_BYTES, stream);
  if (e != hipSuccess) fprintf(stderr, "cooperative launch failed: %s (grid %d)\n", hipGetErrorString(e), grid_blocks);
}
```

```cpp
#include <hip/hip_runtime.h>
#include <hip/hip_bf16.h>
#include <hip/hip_cooperative_groups.h>
#include <cstdio>
#include <cstdint>
#include <cmath>
namespace cg = cooperative_groups;

#define LAS __attribute__((address_space(3)))
typedef unsigned short bf16_t;
typedef short bf16x8 __attribute__((ext_vector_type(8)));
typedef short s16x4 __attribute__((ext_vector_type(4)));
typedef float f32x4 __attribute__((ext_vector_type(4)));
typedef float f32x2 __attribute__((ext_vector_type(2)));
typedef float f32x16 __attribute__((ext_vector_type(16)));
typedef unsigned u32x4 __attribute__((ext_vector_type(4)));
typedef unsigned u32x2 __attribute__((ext_vector_type(2)));

__constant__ float INV64[64] = {1.000000000e+00f, 8.659643531e-01f, 7.498942018e-01f, 6.493816376e-01f, 5.623413324e-01f, 4.869675338e-01f, 4.216965139e-01f, 3.651741147e-01f, 3.162277639e-01f, 2.738419771e-01f, 2.371373773e-01f, 2.053525001e-01f, 1.778279394e-01f, 1.539926529e-01f, 1.333521456e-01f, 1.154781953e-01f, 1.000000015e-01f, 8.659642935e-02f, 7.498942316e-02f, 6.493816525e-02f, 5.623413250e-02f, 4.869675264e-02f, 4.216964915e-02f, 3.651741147e-02f, 3.162277490e-02f, 2.738419548e-02f, 2.371373773e-02f, 2.053525113e-02f, 1.778279431e-02f, 1.539926510e-02f, 1.333521400e-02f, 1.154781971e-02f, 9.999999776e-03f, 8.659643121e-03f, 7.498942316e-03f, 6.493816152e-03f, 5.623413250e-03f, 4.869675264e-03f, 4.216964822e-03f, 3.651741194e-03f, 3.162277630e-03f, 2.738419687e-03f, 2.371373819e-03f, 2.053525066e-03f, 1.778279431e-03f, 1.539926510e-03f, 1.333521446e-03f, 1.154782018e-03f, 1.000000047e-03f, 8.659643354e-04f, 7.498941850e-04f, 6.493816036e-04f, 5.623413017e-04f, 4.869675322e-04f, 4.216965172e-04f, 3.651741135e-04f, 3.162277571e-04f, 2.738419571e-04f, 2.371373703e-04f, 2.053525095e-04f, 1.778279402e-04f, 1.539926598e-04f, 1.333521504e-04f, 1.154782003e-04f};
__constant__ float INV32[32] = {1.000000000e+00f, 7.498942018e-01f, 5.623413324e-01f, 4.216965139e-01f, 3.162277639e-01f, 2.371373773e-01f, 1.778279394e-01f, 1.333521456e-01f, 1.000000015e-01f, 7.498942316e-02f, 5.623413250e-02f, 4.216964915e-02f, 3.162277490e-02f, 2.371373773e-02f, 1.778279431e-02f, 1.333521400e-02f, 9.999999776e-03f, 7.498942316e-03f, 5.623413250e-03f, 4.216964822e-03f, 3.162277630e-03f, 2.371373819e-03f, 1.778279431e-03f, 1.333521446e-03f, 1.000000047e-03f, 7.498941850e-04f, 5.623413017e-04f, 4.216965172e-04f, 3.162277571e-04f, 2.371373703e-04f, 1.778279402e-04f, 1.333521504e-04f};

constexpr int DM = 2048, SEQ = 8192, NB = 2, NTOK = NB * SEQ, DEPTH = 4;
constexpr int INC = 7168, GMC = 8192, N1 = INC + GMC;
constexpr float EPS = 1e-6f;
constexpr int QA = 0, KA = 512, VA = 768, GA = 1024, QB_ = 1536, KB_ = 2048, VB_ = 2560, GB_ = 3072, QC = 3584, KC = 4096, VC = 4352, GC = 4608, QD = 5120, KD = 5632, VD = 6144, GD = 6656;

constexpr size_t WS_WT1 = 0;
constexpr size_t WS_WT2 = WS_WT1 + (size_t)DEPTH * N1 * DM * 2;
constexpr size_t WS_WT3 = WS_WT2 + (size_t)DEPTH * DM * DM * 2;
constexpr size_t WS_H = WS_WT3 + (size_t)DEPTH * DM * DM * 2;
constexpr size_t WS_QKVG = WS_H + (size_t)NTOK * DM * 2;
constexpr size_t WS_MG = WS_QKVG + (size_t)NTOK * INC * 2;
constexpr size_t WS_PO = WS_MG + (size_t)NTOK * GMC * 2;
constexpr size_t WS_PLSE = WS_PO + (size_t)3 * NTOK * 512 * 2;
constexpr size_t WS_ADA = WS_PLSE + (size_t)3 * NTOK * 4 * 4;
constexpr size_t WS_END = WS_ADA + (size_t)DEPTH * NB * 3 * DM * 4;

__device__ __forceinline__ unsigned cvt_pk_bf16(float lo, float hi) { unsigned r; asm volatile("v_cvt_pk_bf16_f32 %0, %1, %2" : "=v"(r) : "v"(lo), "v"(hi)); return r; }
__device__ __forceinline__ float bf_lo(unsigned w) { return __uint_as_float(w << 16); }
__device__ __forceinline__ float bf_hi(unsigned w) { return __uint_as_float(w & 0xffff0000u); }
__device__ __forceinline__ float bf2f(bf16_t v) { return __uint_as_float(((unsigned)v) << 16); }
__device__ __forceinline__ bf16_t f2bf(float f) { return (bf16_t)(cvt_pk_bf16(f, 0.f) & 0xffffu); }
__device__ __forceinline__ float sigmoidf_(float v) { return __builtin_amdgcn_rcpf(1.0f + __expf(-v)); }

namespace pg8 {
constexpr int BM = 256, BK = 64, HALF = 128, HTB = HALF * BK * 2, STAGE_BYTES = 8 * HTB, NXCD = 8, WGM = 8;
__host__ __device__ __forceinline__ int lds_byte(int r, int c) { const int st = (r >> 4) * 2 + (c >> 5), rr = r & 15, cc = c & 31, ob = rr * 64 + cc * 2; return st * 1024 + (ob ^ (((ob >> 9) & 1) << 5)); }
__host__ __device__ __forceinline__ void stage_rc(int b, int& R, int& C) { const int st = b / 1024, sb = b % 1024, swz = sb ^ (((sb >> 9) & 1) << 5); R = (st >> 1) * 16 + swz / 64; C = (st & 1) * 32 + (swz % 64) / 2; }
__host__ __device__ __forceinline__ int perm32(int rho) { const int n = rho >> 4, i = rho & 15; return 8 * (i >> 2) + 4 * n + (i & 3); }

struct Unit { int pm, pn, seg; };
struct Gemm { const bf16_t* A; const bf16_t* Bt; int ld; int kseg; };

struct Order {
    int nM, nN, nwg, G, c, segshift;
    __device__ void init(int M, int N, int G_, int c_, int segshift_) { nM = M / BM; nN = N / BM; nwg = nM * nN; G = G_; c = c_; segshift = segshift_; }
    __device__ bool next(int i, Unit& u) const {
        const long L = (long)(i >> segshift) * G + c; if (L >= nwg) return false;
        int wgid = (int)L; { const int q = nwg / NXCD, r = nwg % NXCD, xcd = wgid % NXCD, off = wgid / NXCD; wgid = (xcd < r ? xcd * (q + 1) : r * (q + 1) + (xcd - r) * q) + off; }
        const int nig = WGM * nN, gid = wgid / nig, fm = gid * WGM, gsz = (nM - fm) < WGM ? (nM - fm) : WGM;
        u.pm = fm + ((wgid % nig) % gsz); u.pn = (wgid % nig) / gsz; u.seg = i & ((1 << segshift) - 1); return true;
    }
};


__host__ __device__ __forceinline__ int g1_row(int n) {
    const bool rope = (n < 768) || (n >= 1536 && n < 2560);
    if (!rope) return n;
    const int hb = n & ~127, d = n & 127, dd = d & 63;
    return hb + 8 * (dd >> 2) + (dd & 3) + ((d >> 6) << 2);
}
struct EpiG1 {
    static constexpr bool PERM = true;
    bf16_t* qkvg; bf16_t* mg;
    __device__ __forceinline__ bool zero_after(const Unit&) const { return true; }
    __device__ __forceinline__ void operator()(f32x4 (&acc)[2][2][4][2], const Unit& u, int wr, int wc, int fr, int fq) const {
        const int row0 = u.pm * BM + wr * 64 + fr; const int pn = u.pn;
        if (pn <= 2 || (pn >= 6 && pn <= 9)) {
            const int g4 = (4 * wc + fq) * 4;
            const f32x4 inv = *(const f32x4*)(INV64 + g4);
#pragma unroll
            for (int ai = 0; ai < 2; ++ai)
#pragma unroll
                for (int m = 0; m < 4; ++m) { const int row = row0 + ai * HALF + m * 16; const float pos = (float)(row & (SEQ - 1));
                    bf16_t* rowp = qkvg + (size_t)row * INC + pn * BM + g4;
                    f32x4 cs, sn;
#pragma unroll
                    for (int e = 0; e < 4; ++e) { const float ang = pos * inv[e]; double rev = (double)ang * 0.15915494309189535; rev -= __builtin_rint(rev);
                        const float fr_ = (float)rev; sn[e] = __builtin_amdgcn_sinf(fr_); cs[e] = __builtin_amdgcn_cosf(fr_); }
#pragma unroll
                    for (int bj = 0; bj < 2; ++bj) { const f32x4 a = acc[ai][bj][m][0], b = acc[ai][bj][m][1];
                        const f32x4 oa = a * cs - b * sn, ob = b * cs + a * sn;
                        u32x2 wa, wb; wa.x = cvt_pk_bf16(oa[0], oa[1]); wa.y = cvt_pk_bf16(oa[2], oa[3]); wb.x = cvt_pk_bf16(ob[0], ob[1]); wb.y = cvt_pk_bf16(ob[2], ob[3]);
                        *(u32x2*)(rowp + bj * HALF) = wa; *(u32x2*)(rowp + bj * HALF + 64) = wb; } }
            return;
        }
        int mode, ldc, colt; bf16_t* base;
        if (pn < 28) { base = qkvg; ldc = INC; colt = pn * BM; mode = (pn == 4 || pn == 5 || pn == 12 || pn == 13 || pn == 18 || pn == 19 || pn == 26 || pn == 27) ? 1 : 0; }
        else { base = mg; ldc = GMC; colt = (pn - 28) * BM; mode = 2; }
        const int col0 = colt + wc * 32 + 8 * fq;
#pragma unroll
        for (int ai = 0; ai < 2; ++ai)
#pragma unroll
            for (int m = 0; m < 4; ++m) { bf16_t* rowp = base + (size_t)(row0 + ai * HALF + m * 16) * ldc + col0;
#pragma unroll
                for (int bj = 0; bj < 2; ++bj) { f32x4 v0 = acc[ai][bj][m][0], v1 = acc[ai][bj][m][1];
                    if (mode != 0) {
#pragma unroll
                        for (int e = 0; e < 4; ++e) { const float s0 = sigmoidf_(v0[e]), s1 = sigmoidf_(v1[e]); v0[e] = (mode == 1) ? v0[e] * s0 : s0; v1[e] = (mode == 1) ? v1[e] * s1 : s1; }
                    }
                    u32x4 w; w.x = cvt_pk_bf16(v0[0], v0[1]); w.y = cvt_pk_bf16(v0[2], v0[3]); w.z = cvt_pk_bf16(v1[0], v1[1]); w.w = cvt_pk_bf16(v1[2], v1[3]);
                    *(u32x4*)(rowp + bj * HALF) = w; } }
    }
};
struct EpiG2 {
    static constexpr bool PERM = true;
    const bf16_t* mg; bf16_t* out;
    __device__ __forceinline__ bool zero_after(const Unit& u) const { return u.seg == 3; }
    __device__ __forceinline__ void operator()(f32x4 (&acc)[2][2][4][2], const Unit& u, int wr, int wc, int fr, int fq) const {
        const int row0 = u.pm * BM + wr * 64 + fr, col0 = u.pn * BM + wc * 32 + 8 * fq, seg = u.seg;
#pragma unroll
        for (int ai = 0; ai < 2; ++ai)
#pragma unroll
            for (int m = 0; m < 4; ++m) { const int row = row0 + ai * HALF + m * 16; const bf16_t* gp = mg + (size_t)row * GMC + seg * DM + col0;
#pragma unroll
                for (int bj = 0; bj < 2; ++bj) {
                    const u32x4 ga = *(const u32x4*)(gp + bj * HALF);
                    float f[8] = {bf_lo(ga.x), bf_hi(ga.x), bf_lo(ga.y), bf_hi(ga.y), bf_lo(ga.z), bf_hi(ga.z), bf_lo(ga.w), bf_hi(ga.w)};
                    if (seg < 3) { const u32x4 gb = *(const u32x4*)(gp + DM + bj * HALF);
                        const float d[8] = {bf_lo(gb.x), bf_hi(gb.x), bf_lo(gb.y), bf_hi(gb.y), bf_lo(gb.z), bf_hi(gb.z), bf_lo(gb.w), bf_hi(gb.w)};
#pragma unroll
                        for (int e = 0; e < 8; ++e) f[e] = f[e] * __builtin_amdgcn_rcpf(d[e]); }
                    f32x4 v0 = acc[ai][bj][m][0], v1 = acc[ai][bj][m][1];
                    v0[0] *= f[0]; v0[1] *= f[1]; v0[2] *= f[2]; v0[3] *= f[3]; v1[0] *= f[4]; v1[1] *= f[5]; v1[2] *= f[6]; v1[3] *= f[7];
                    acc[ai][bj][m][0] = v0; acc[ai][bj][m][1] = v1;
                    if (seg == 3) { u32x4 w; w.x = cvt_pk_bf16(v0[0], v0[1]); w.y = cvt_pk_bf16(v0[2], v0[3]); w.z = cvt_pk_bf16(v1[0], v1[1]); w.w = cvt_pk_bf16(v1[2], v1[3]);
                        *(u32x4*)(out + (size_t)row * DM + col0 + bj * HALF) = w; } } }
    }
};
struct EpiG3 {
    static constexpr bool PERM = false;
    const float* xin; float* xout; const float* gate;
    __device__ __forceinline__ bool zero_after(const Unit&) const { return true; }
    __device__ __forceinline__ void operator()(f32x4 (&acc)[2][2][4][2], const Unit& u, int wr, int wc, int fr, int fq) const {
        const int col0 = u.pn * BM + wc * 32 + 4 * fq;
        const float* gp = gate + (size_t)((u.pm * BM) >> 13) * (3 * DM) + col0;
        f32x4 gv[2][2];
#pragma unroll
        for (int bj = 0; bj < 2; ++bj)
#pragma unroll
            for (int n = 0; n < 2; ++n) gv[bj][n] = *(const f32x4*)(gp + bj * HALF + n * 16);
#pragma unroll
        for (int ai = 0; ai < 2; ++ai)
#pragma unroll
            for (int m = 0; m < 4; ++m) { const size_t off = (size_t)(u.pm * BM + ai * HALF + wr * 64 + m * 16 + fr) * DM + col0;
#pragma unroll
                for (int bj = 0; bj < 2; ++bj)
#pragma unroll
                    for (int n = 0; n < 2; ++n) { const f32x4 xo = *(const f32x4*)(xin + off + bj * HALF + n * 16);
                        *(f32x4*)(xout + off + bj * HALF + n * 16) = xo + gv[bj][n] * acc[ai][bj][m][n]; }
                if (m & 1) asm volatile("" ::: "memory"); }
    }
};

template <class Epi>
__device__ __forceinline__ void gemm_phase(LAS unsigned char* lds, const Gemm g, const Order& S, const Epi& E) {
    int tid = threadIdx.x; asm volatile("" : "+v"(tid));
    const int wid = __builtin_amdgcn_readfirstlane(tid >> 6), lane = tid & 63, wr = wid >> 2, wc = wid & 3, fr = lane & 15, fq = lane >> 4;
    const int K = g.ld, nt = g.kseg / BK;
    unsigned voffA[2], voffB[2];
#pragma unroll
    for (int i = 0; i < 2; ++i) { int R, C; stage_rc(tid * 16 + i * 8192, R, C); const int Rb = Epi::PERM ? ((R & ~31) + perm32(R & 31)) : R;
        voffA[i] = (unsigned)(R * K + C) * 2u; voffB[i] = (unsigned)(Rb * K + C) * 2u; }
    const size_t kstep = (size_t)(BK * 2);
    const size_t hstep = (size_t)HALF * K * 2;
    const size_t tstep = 2 * hstep;
    const size_t sstep = (size_t)g.kseg * 2;
    const unsigned ldsw = (unsigned)wid * 1024u;
    const int aoff = lds_byte(wr * 64 + fr, fq * 8), boff = lds_byte(wc * 32 + fr, fq * 8);
#define PG8_SA(b, h) (((b) * 2 + (h)) * HTB)
#define PG8_SB(b, h) ((4 + (b) * 2 + (h)) * HTB)
#define PG8_STAGE(bufoff, gbase, voff) do { _Pragma("unroll") for (int _i = 0; _i < 2; ++_i) \
        __builtin_amdgcn_global_load_lds((const unsigned*)((const char*)(gbase) + (voff)[_i]), (LAS unsigned*)(lds + (bufoff) + ldsw + _i * 8192), 16, 0, 0); } while (0)
#define PG8_LDA(dst, b, h) do { _Pragma("unroll") for (int m = 0; m < 4; ++m) _Pragma("unroll") for (int k = 0; k < 2; ++k) dst[m][k] = *(const LAS bf16x8*)(lds + PG8_SA(b, h) + aoff + m * 2048 + k * 1024); } while (0)
#define PG8_LDB(dst, b, h) do { _Pragma("unroll") for (int n = 0; n < 2; ++n) _Pragma("unroll") for (int k = 0; k < 2; ++k) dst[n][k] = *(const LAS bf16x8*)(lds + PG8_SB(b, h) + boff + n * 2048 + k * 1024); } while (0)
#define PG8_MMA(ai, bj, At, Bt) do { __builtin_amdgcn_s_setprio(1); _Pragma("unroll") for (int m = 0; m < 4; ++m) _Pragma("unroll") for (int n = 0; n < 2; ++n) _Pragma("unroll") for (int k = 0; k < 2; ++k) \
        acc[ai][bj][m][n] = __builtin_amdgcn_mfma_f32_16x16x32_bf16(Bt[n][k], At[m][k], acc[ai][bj][m][n], 0, 0, 0); __builtin_amdgcn_s_setprio(0); } while (0)
#define PG8_WAIT_V(n) asm volatile("s_waitcnt vmcnt(" #n ")" ::: "memory")
#define PG8_WAIT_L(n) asm volatile("s_waitcnt lgkmcnt(" #n ")" ::: "memory")
#define PG8_BAR __builtin_amdgcn_s_barrier()
#define PG8_SCHED __builtin_amdgcn_sched_barrier(0)
#define PG8_UA(u) ((const char*)g.A + (size_t)(u).pm * tstep + (size_t)(u).seg * sstep)
#define PG8_UB(u) ((const char*)g.Bt + (size_t)(u).pn * tstep + (size_t)(u).seg * sstep)
    Unit cur, nxt; int ui = 0;
    if (!S.next(0, cur)) return;
    f32x4 acc[2][2][4][2];
#pragma unroll
    for (int a = 0; a < 2; ++a)
#pragma unroll
        for (int b = 0; b < 2; ++b)
#pragma unroll
            for (int m = 0; m < 4; ++m)
#pragma unroll
                for (int n = 0; n < 2; ++n) acc[a][b][m][n] = (f32x4){0.f, 0.f, 0.f, 0.f};
    bf16x8 At[4][2], B0[2][2], B1[2][2];
    const char* cA = PG8_UA(cur); const char* cB = PG8_UB(cur);
    PG8_STAGE(PG8_SB(0, 0), cB, voffB); PG8_STAGE(PG8_SB(0, 1), cB + hstep, voffB); PG8_STAGE(PG8_SA(0, 0), cA, voffA); PG8_STAGE(PG8_SA(0, 1), cA + hstep, voffA);
    if (wr == 1) PG8_BAR;
    PG8_WAIT_V(2); PG8_BAR;
    PG8_STAGE(PG8_SB(1, 0), cB + kstep, voffB); PG8_STAGE(PG8_SA(1, 0), cA + kstep, voffA); PG8_STAGE(PG8_SB(1, 1), cB + hstep + kstep, voffB);
    PG8_WAIT_V(6); PG8_BAR;
    for (;;) {
        const bool has_next = S.next(ui + 1, nxt);
        const char* nA = has_next ? PG8_UA(nxt) : cA; const char* nB = has_next ? PG8_UB(nxt) : cB;
        for (int t = 0; t < nt; t += 2) {
            const bool last = (t == nt - 2);
            const char* a1 = cA + (size_t)(t + 1) * kstep;
            const char* a2 = last ? nA : cA + (size_t)(t + 2) * kstep; const char* b2 = last ? nB : cB + (size_t)(t + 2) * kstep;
            const char* a3 = a2 + kstep; const char* b3 = b2 + kstep;
            PG8_LDB(B0, 0, 0); PG8_LDB(B1, 0, 1); PG8_SCHED; PG8_LDA(At, 0, 0); PG8_STAGE(PG8_SA(1, 1), a1 + hstep, voffA);
            PG8_WAIT_V(8); PG8_WAIT_L(0); PG8_BAR; PG8_MMA(0, 0, At, B0); PG8_MMA(0, 1, At, B1); PG8_BAR; PG8_SCHED;
            PG8_LDA(At, 0, 1); PG8_STAGE(PG8_SB(0, 0), b2, voffB); PG8_STAGE(PG8_SB(0, 1), b2 + hstep, voffB); PG8_STAGE(PG8_SA(0, 0), a2, voffA);
            PG8_WAIT_V(8); PG8_WAIT_L(0); PG8_BAR; PG8_MMA(1, 0, At, B0); PG8_MMA(1, 1, At, B1); PG8_BAR; PG8_SCHED;
            PG8_LDB(B0, 1, 0); PG8_LDB(B1, 1, 1); PG8_SCHED; PG8_LDA(At, 1, 0); PG8_STAGE(PG8_SA(0, 1), a2 + hstep, voffA);
            PG8_WAIT_V(8); PG8_WAIT_L(0); PG8_BAR; PG8_MMA(0, 0, At, B0); PG8_MMA(0, 1, At, B1); PG8_BAR; PG8_SCHED;
            PG8_LDA(At, 1, 1); PG8_STAGE(PG8_SB(1, 0), b3, voffB); PG8_STAGE(PG8_SB(1, 1), b3 + hstep, voffB); PG8_STAGE(PG8_SA(1, 0), a3, voffA);
            PG8_WAIT_V(8); PG8_WAIT_L(0); PG8_BAR; PG8_MMA(1, 0, At, B0); PG8_MMA(1, 1, At, B1); PG8_BAR; PG8_SCHED;
        }
        if (wr == 0) PG8_BAR;
        E(acc, cur, wr, wc, fr, fq);
        if (!has_next) break;
        if (E.zero_after(cur)) {
#pragma unroll
            for (int a = 0; a < 2; ++a)
#pragma unroll
                for (int b = 0; b < 2; ++b)
#pragma unroll
                    for (int m = 0; m < 4; ++m)
#pragma unroll
                        for (int n = 0; n < 2; ++n) acc[a][b][m][n] = (f32x4){0.f, 0.f, 0.f, 0.f};
        }
        cur = nxt; cA = nA; cB = nB; ++ui;
        if (wr == 1) PG8_BAR;
    }
    PG8_WAIT_V(0);
    PG8_BAR;
#undef PG8_SA
#undef PG8_SB
#undef PG8_STAGE
#undef PG8_LDA
#undef PG8_LDB
#undef PG8_MMA
#undef PG8_WAIT_V
#undef PG8_WAIT_L
#undef PG8_BAR
#undef PG8_SCHED
#undef PG8_UA
#undef PG8_UB
}
}

namespace att {
constexpr int D = 128, NW = 8, QBLK = 32, KVBLK = 64;
constexpr float SCALE = 0.088388347648318440f;
constexpr float THR = 8.f;
constexpr int SDEPTH = 2;
constexpr size_t SHM_V = KVBLK * D * 2, SHM_K = KVBLK * D * 2, SHM_ATTN = 2 * SHM_V + 2 * SHM_K + NW * 64 * 4;
constexpr float NEGBIG = -1e30f, MFLOOR = -30000.f;
#define KSWZ(row, colB) ((row) * 256 + ((colB) ^ (((row) & 7) << 4)))
#define SBAR() __builtin_amdgcn_sched_barrier(0)
__device__ __forceinline__ int sr_f(int tid) { return tid >> 4; }
__device__ __forceinline__ int crow(int r, int hi) { return (r & 3) + 8 * (r >> 2) + 4 * hi; }
__device__ __forceinline__ unsigned cvtpk(float lo, float hi) { unsigned r; asm volatile("v_cvt_pk_bf16_f32 %0, %1, %2" : "=v"(r) : "v"(lo), "v"(hi)); return r; }

__device__ __forceinline__ void partialSM(f32x16& p0, f32x16& p1, float& m_reg, float& mn, float& alpha) {
  constexpr float C = SCALE * 1.4426950408889634f;
  float pmax = p0[0]; for (int r = 1; r < 16; ++r) pmax = fmaxf(pmax, p0[r]); for (int r = 0; r < 16; ++r) pmax = fmaxf(pmax, p1[r]);
  { auto rr = __builtin_amdgcn_permlane32_swap(__float_as_uint(pmax), __float_as_uint(pmax), false, false);
    pmax = fmaxf(__uint_as_float(rr[0]), __uint_as_float(rr[1])); }
  if (__builtin_expect(__all(pmax - m_reg <= THR / SCALE), 1)) { mn = m_reg; alpha = 1.f; }
  else { mn = fmaxf(m_reg, pmax); alpha = __builtin_amdgcn_exp2f((m_reg - mn) * C); m_reg = mn; }
  float mnC = -mn * C;
  for (int r = 0; r < 16; ++r) p0[r] = fmaf(p0[r], C, mnC); for (int r = 0; r < 16; ++r) p1[r] = fmaf(p1[r], C, mnC);
  for (int r = 0; r < 16; ++r) p0[r] = __builtin_amdgcn_exp2f(p0[r]);
}
__device__ __forceinline__ void finishSM(f32x16& p0, f32x16& p1, float alpha, float& l_reg, bf16x8& pa0, bf16x8& pa1, bf16x8& pa2, bf16x8& pa3) {
  for (int r = 0; r < 16; ++r) p1[r] = __builtin_amdgcn_exp2f(p1[r]);
  float ps = 0; for (int r = 0; r < 16; ++r) ps += p0[r]; for (int r = 0; r < 16; ++r) ps += p1[r];
  { auto rr = __builtin_amdgcn_permlane32_swap(__float_as_uint(ps), __float_as_uint(ps), false, false);
    ps = __uint_as_float(rr[0]) + __uint_as_float(rr[1]); }
  l_reg = l_reg * alpha + ps;
#define PK4(P, BASE, OUT) do { unsigned a0 = cvtpk(P[BASE + 0], P[BASE + 1]), a1 = cvtpk(P[BASE + 2], P[BASE + 3]);   \
    unsigned b0 = cvtpk(P[BASE + 4], P[BASE + 5]), b1 = cvtpk(P[BASE + 6], P[BASE + 7]);                              \
    auto r0 = __builtin_amdgcn_permlane32_swap(a0, b0, false, false); auto r1 = __builtin_amdgcn_permlane32_swap(a1, b1, false, false); \
    u32x4 w = {r0[0], r1[0], r0[1], r1[1]}; OUT = *reinterpret_cast<bf16x8*>(&w); } while (0)
  PK4(p0, 0, pa0); PK4(p0, 8, pa1); PK4(p1, 0, pa2); PK4(p1, 8, pa3);
#undef PK4
}
__device__ __forceinline__ void qkt(f32x16& p0, f32x16& p1, const LAS char* Ks, const bf16x8* qr, int r32, int hi) {
  p0 = f32x16{}; p1 = f32x16{};
  for (int d0 = 0; d0 < 8; ++d0) { int cb = (d0 * 16 + hi * 8) * 2;
    bf16x8 b0 = *reinterpret_cast<const LAS bf16x8*>(Ks + KSWZ(r32, cb));
    bf16x8 b1 = *reinterpret_cast<const LAS bf16x8*>(Ks + KSWZ(32 + r32, cb));
    p0 = __builtin_amdgcn_mfma_f32_32x32x16_bf16(b0, qr[d0], p0, 0, 0, 0);
    p1 = __builtin_amdgcn_mfma_f32_32x32x16_bf16(b1, qr[d0], p1, 0, 0, 0); }
}
__device__ __forceinline__ int v_st(int k, int c) { const int kk = (k & ~0xC) | ((k & 4) << 1) | ((k & 8) >> 1); return ((kk >> 3) * 4 + (c >> 5)) * 512 + ((kk & 7) * 32 + (c & 31)) * 2; }
__device__ __forceinline__ int v_rd_base(int lane) { return ((lane & 3) << 3) | (((lane >> 2) & 3) << 6) | (((lane >> 4) & 1) << 5) | (((lane >> 5) & 1) << 8); }
constexpr int v_rd_off(int d0, int ks, int half) { return d0 * 512 + ks * 4096 + half * 2048; }
template <int OFF> __device__ __forceinline__ s16x4 tr_read(int vb) {
  s16x4 r; asm volatile("ds_read_b64_tr_b16 %0, %1 offset:%2" : "=&v"(r) : "v"(vb), "i"(OFF) : "memory"); return r;
}
template <int D0> __device__ __forceinline__ void pv_one(f32x16& od, int vb, bf16x8 pa0, bf16x8 pa1, bf16x8 pa2, bf16x8 pa3) {
  const s16x4 l0 = tr_read<v_rd_off(D0, 0, 0)>(vb), h0 = tr_read<v_rd_off(D0, 0, 1)>(vb), l1 = tr_read<v_rd_off(D0, 1, 0)>(vb), h1 = tr_read<v_rd_off(D0, 1, 1)>(vb);
  const s16x4 l2 = tr_read<v_rd_off(D0, 2, 0)>(vb), h2 = tr_read<v_rd_off(D0, 2, 1)>(vb), l3 = tr_read<v_rd_off(D0, 3, 0)>(vb), h3 = tr_read<v_rd_off(D0, 3, 1)>(vb);
  asm volatile("s_waitcnt lgkmcnt(0)" ::: "memory"); SBAR();
#define PK(L, H) (bf16x8){L[0], L[1], L[2], L[3], H[0], H[1], H[2], H[3]}
  od = __builtin_amdgcn_mfma_f32_32x32x16_bf16(pa0, PK(l0, h0), od, 0, 0, 0);
  od = __builtin_amdgcn_mfma_f32_32x32x16_bf16(pa1, PK(l1, h1), od, 0, 0, 0);
  od = __builtin_amdgcn_mfma_f32_32x32x16_bf16(pa2, PK(l2, h2), od, 0, 0, 0);
  od = __builtin_amdgcn_mfma_f32_32x32x16_bf16(pa3, PK(l3, h3), od, 0, 0, 0);
#undef PK
}
__device__ __forceinline__ void pv_d0(f32x16* o, int vb, bf16x8 pa0, bf16x8 pa1, bf16x8 pa2, bf16x8 pa3) {
  pv_one<0>(o[0], vb, pa0, pa1, pa2, pa3); pv_one<1>(o[1], vb, pa0, pa1, pa2, pa3); pv_one<2>(o[2], vb, pa0, pa1, pa2, pa3); pv_one<3>(o[3], vb, pa0, pa1, pa2, pa3);
}

struct MaskNone { static constexpr bool ANY = false; __device__ __forceinline__ void apply(f32x16&, f32x16&, int, int, int, int) const {} };
struct MaskBand {
  static constexpr bool ANY = true; int d0, reach;
  __device__ __forceinline__ void apply(f32x16& p0, f32x16& p1, int tile, int wid, int r32, int hi) const {
    const int base = d0 + tile * 64 - (wid * 32 + r32) + 4 * hi + reach; const unsigned lim = 2u * (unsigned)reach;
#pragma unroll
    for (int r = 0; r < 16; ++r) { const int k = (r & 3) + 8 * (r >> 2);
      if ((unsigned)(base + k) > lim) p0[r] = NEGBIG;
      if ((unsigned)(base + k + 32) > lim) p1[r] = NEGBIG; }
  }
};
struct MaskNA {
  static constexpr bool ANY = true; int qrow0, krow0; const LAS float* tab;
  __device__ __forceinline__ void apply(f32x16& p0, f32x16& p1, int tile, int wid, int r32, int hi) const {
    const int qr = qrow0 + (wid >> 1), kr = krow0 + tile; int rs = qr - 4; rs = rs < 0 ? 0 : (rs > 120 ? 120 : rs);
    if (kr < rs || kr >= rs + 8) {
#pragma unroll
      for (int r = 0; r < 16; ++r) { p0[r] = NEGBIG; p1[r] = NEGBIG; }
    } else {
      const int qc = (wid & 1) * 32 + r32; int cs = qc - 8; cs = cs < 0 ? 0 : (cs > 48 ? 48 : cs);
      const LAS float* trow = tab + (kr - qr + 7) * 128 + 63 - qc + 4 * hi;
      const int cb = 4 * hi - cs;
#pragma unroll
      for (int r = 0; r < 16; ++r) { const int k = (r & 3) + 8 * (r >> 2);
        p0[r] = ((unsigned)(cb + k) < 16u) ? p0[r] + trow[k] : NEGBIG;
        p1[r] = ((unsigned)(cb + k + 32) < 16u) ? p1[r] + trow[k + 32] : NEGBIG; }
    }
  }
};
struct OutGated {
  bf16_t* y; const bf16_t* gate;
  __device__ __forceinline__ void store4(int row, int col, f32x4 v) const {
    const u32x2 g = *(const u32x2*)((const char*)gate + (unsigned)(row * INC + col) * 2u);
    u32x2 w; w.x = cvt_pk_bf16(v.x * bf_lo(g.x), v.y * bf_hi(g.x)); w.y = cvt_pk_bf16(v.z * bf_lo(g.y), v.w * bf_hi(g.y));
    *(u32x2*)((char*)y + (unsigned)(row * DM + col) * 2u) = w; }
  __device__ __forceinline__ void lse(int, float, float) const {}
};
struct OutPartial {
  bf16_t* po; float* plse; int dil;
  __device__ __forceinline__ void store4(int row, int col, f32x4 v) const {
    u32x2 w; w.x = cvt_pk_bf16(v.x, v.y); w.y = cvt_pk_bf16(v.z, v.w);
    *(u32x2*)((char*)po + (unsigned)(row * dil * 512 + col) * 2u) = w; }
  __device__ __forceinline__ void lse(int row, float m, float l) const { plse[(unsigned)(row * dil * 4)] = m * SCALE + __logf(l); }
};
constexpr int TAB_OFF = 67584, STG_OFF = 75776, STG_STRIDE = 68, STG_WAVE = 32 * STG_STRIDE * 4;

template <class Mask, class Out, int SD = 2>
__device__ __forceinline__ void attn_unit(const bf16_t* __restrict__ Qb, const bf16_t* __restrict__ Kh, const bf16_t* __restrict__ Vh, const int ldq, const int ldk,
                                          const int NT, const float m_init, const float l_init, const Mask& mask, const Out& out, LAS char* lds) {
  int tid = threadIdx.x; asm volatile("" : "+v"(tid));
  const int wid = __builtin_amdgcn_readfirstlane(tid >> 6), lane = tid & 63, r32 = lane & 31, hi = lane >> 5;
  LAS char* V_lds = lds; LAS char* K_lds = lds + 2 * SHM_V;
  LAS float* ws = (LAS float*)(lds + 2 * SHM_V + 2 * SHM_K) + wid * 64; LAS float* li_l = ws; LAS float* al_l = ws + 32;
  float m_reg = m_init, l_reg = l_init; f32x16 o[4] = {}; bf16x8 qr[8];
  { const unsigned qoff = (unsigned)((wid * QBLK + r32) * ldq + hi * 8) * 2u;
#pragma unroll
    for (int d0 = 0; d0 < 8; ++d0) qr[d0] = *reinterpret_cast<const bf16x8*>((const char*)Qb + qoff + d0 * 32); }
  const unsigned kvoff = (unsigned)(sr_f(tid) * ldk + (tid & 15) * 8) * 2u; const size_t tileb = (size_t)ldk * 2, half32 = tileb * 32;
  const int sr = tid >> 4, sc = (tid & 15) * 8, vst0 = v_st(sr, sc), vst1 = v_st(32 + sr, sc);
  const int vb0 = (int)(uintptr_t)V_lds + v_rd_base(lane);
  struct { bf16x8 vs0, vs1, ks0, ks1; } sr_[SD];
#define SLOAD(i, k0) do { const char* vp_ = (const char*)Vh + (size_t)(k0) * tileb; const char* kp_ = (const char*)Kh + (size_t)(k0) * tileb; \
    sr_[i].vs0 = *reinterpret_cast<const bf16x8*>(vp_ + kvoff); sr_[i].vs1 = *reinterpret_cast<const bf16x8*>(vp_ + half32 + kvoff); \
    sr_[i].ks0 = *reinterpret_cast<const bf16x8*>(kp_ + kvoff); sr_[i].ks1 = *reinterpret_cast<const bf16x8*>(kp_ + half32 + kvoff); } while (0)
#define SWRITE(b, i) do { *(LAS bf16x8*)(V_lds + (b) * SHM_V + vst0) = sr_[i].vs0;          \
    *(LAS bf16x8*)(V_lds + (b) * SHM_V + vst1) = sr_[i].vs1; int kc = sc * 2;               \
    *(LAS bf16x8*)(K_lds + (b) * SHM_K + KSWZ(sr, kc)) = sr_[i].ks0;                       \
    *(LAS bf16x8*)(K_lds + (b) * SHM_K + KSWZ(32 + sr, kc)) = sr_[i].ks1; } while (0)
#define SWAIT() do { if constexpr (SD == 2) asm volatile("s_waitcnt vmcnt(4)" ::: "memory"); else asm volatile("s_waitcnt vmcnt(0)" ::: "memory"); } while (0)
#define RESC(a) do { if (__any((a) < 1.f)) { if (hi == 0) al_l[r32] = (a); asm volatile("s_waitcnt lgkmcnt(0)" ::: "memory"); \
    for (int d = 0; d < 4; ++d) for (int r = 0; r < 16; ++r) o[d][r] *= al_l[crow(r, hi)]; } } while (0)
  f32x16 pA0, pA1, pB0, pB1; float mnA, mnB, alA, alB; bf16x8 pa0, pa1, pa2, pa3;
  constexpr int SE = 0, SO = SD - 1;
  SLOAD(SE, 0); asm volatile("s_waitcnt vmcnt(0)" ::: "memory"); SWRITE(0, SE); __syncthreads();
  qkt(pA0, pA1, K_lds, qr, r32, hi); mask.apply(pA0, pA1, 0, wid, r32, hi); partialSM(pA0, pA1, m_reg, mnA, alA);
  SLOAD(SO, KVBLK); if constexpr (SD == 2) { if (2 < NT) SLOAD(SE, 2 * KVBLK); }
  SWAIT(); SWRITE(1, SO); __syncthreads();
  for (int j = 1; j + 1 < NT; j += 2) {
    SBAR(); qkt(pB0, pB1, K_lds + SHM_K, qr, r32, hi);
    finishSM(pA0, pA1, alA, l_reg, pa0, pa1, pa2, pa3); SBAR();
    SLOAD(SO, (j + SD) * KVBLK); SBAR();
    pv_d0(o, vb0, pa0, pa1, pa2, pa3); mask.apply(pB0, pB1, j, wid, r32, hi); partialSM(pB0, pB1, m_reg, mnB, alB);
    __syncthreads(); SWAIT(); SWRITE(0, SE);
    RESC(alB); __syncthreads();
    SBAR(); qkt(pA0, pA1, K_lds, qr, r32, hi);
    finishSM(pB0, pB1, alB, l_reg, pa0, pa1, pa2, pa3); SBAR();
    if (SD == 1 || j + 3 < NT) SLOAD(SE, (j + 1 + SD) * KVBLK); SBAR();
    pv_d0(o, vb0 + (int)SHM_V, pa0, pa1, pa2, pa3); mask.apply(pA0, pA1, j + 1, wid, r32, hi); partialSM(pA0, pA1, m_reg, mnA, alA);
    __syncthreads(); SWAIT(); SWRITE(1, SO);
    RESC(alA); __syncthreads();
  }
  SBAR(); qkt(pB0, pB1, K_lds + SHM_K, qr, r32, hi);
  finishSM(pA0, pA1, alA, l_reg, pa0, pa1, pa2, pa3); SBAR();
  pv_d0(o, vb0, pa0, pa1, pa2, pa3); mask.apply(pB0, pB1, NT - 1, wid, r32, hi); partialSM(pB0, pB1, m_reg, mnB, alB);
  __syncthreads(); RESC(alB);
  finishSM(pB0, pB1, alB, l_reg, pa0, pa1, pa2, pa3); SBAR();
  pv_d0(o, vb0 + (int)SHM_V, pa0, pa1, pa2, pa3);
  if (hi == 0) { li_l[r32] = l_reg; out.lse(wid * QBLK + r32, m_reg, l_reg); } asm volatile("s_waitcnt lgkmcnt(0)" ::: "memory");
  float rli[16];
#pragma unroll
  for (int r = 0; r < 16; ++r) rli[r] = __builtin_amdgcn_rcpf(li_l[crow(r, hi)]);
  LAS float* stg = (LAS float*)(lds + STG_OFF + wid * STG_WAVE);
#pragma unroll
  for (int half = 0; half < 2; ++half) {
#pragma unroll
    for (int r = 0; r < 16; ++r) {
      stg[crow(r, hi) * STG_STRIDE + r32] = o[half * 2][r] * rli[r]; stg[crow(r, hi) * STG_STRIDE + 32 + r32] = o[half * 2 + 1][r] * rli[r]; }
    asm volatile("s_waitcnt lgkmcnt(0)" ::: "memory");
#pragma unroll
    for (int i = 0; i < 8; ++i) { const int row = i * 4 + (lane >> 4), c4 = (lane & 15) * 4;
      const f32x4 v = *(const LAS f32x4*)(stg + row * STG_STRIDE + c4);
      out.store4(wid * QBLK + row, half * 64 + c4, v); }
    asm volatile("s_waitcnt lgkmcnt(0)" ::: "memory");
  }
#undef SLOAD
#undef SWRITE
#undef SWAIT
#undef RESC
}
}

#ifndef PH_A
#define PH_A 1
#endif
#ifndef PH_B
#define PH_B 1
#endif
#ifndef PH_C
#define PH_C 1
#endif
#ifndef PH_D
#define PH_D 1
#endif
#ifndef PH_G1
#define PH_G1 1
#endif
#ifndef PH_G2
#define PH_G2 1
#endif
#ifndef PH_G3
#define PH_G3 1
#endif

#ifndef PROBE
#define PROBE 0
#endif
#define REPS(k) ((PROBE == (k)) ? 2 : 1)
#define GSYNC() do { grid.sync(); if (PROBE == 1) grid.sync(); } while (0)

struct Params {
  const float *x, *c, *norm_g, *w_ada, *b_ada, *w_in, *a_sink, *c_q_norm, *c_k_norm, *d_rel_bias, *w_gm, *w_branch, *w_out, *final_g;
  float* out; unsigned char* ws;
};
constexpr int LDS_BYTES = 147456;

__device__ __forceinline__ float wave_sum(float v) {
#pragma unroll
  for (int o = 1; o < 64; o <<= 1) v += __shfl_xor(v, o);
  return v;
}
template <bool G1PERM>
__device__ __forceinline__ void transpose_item(const float* __restrict__ W, int N, bf16_t* __restrict__ WT, int dpitch, int row_off, int coff, LAS float* scr, int item, int lane) {
  const int nblk = N / 32, kb = item / nblk, nb = item % nblk, k0 = 64 * kb, n0 = 32 * nb;
#pragma unroll 8
  for (int i = 0; i < 32; ++i) { const int kk = 2 * i + (lane >> 5); scr[kk * 33 + (lane & 31)] = W[(size_t)(k0 + kk) * N + n0 + (lane & 31)]; }
  asm volatile("s_waitcnt lgkmcnt(0)" ::: "memory");
  const int c = lane & 7;
#pragma unroll
  for (int j = 0; j < 4; ++j) { const int n = (lane >> 3) + 8 * j; const LAS float* s = scr + (8 * c) * 33 + n;
    u32x4 o; o.x = cvt_pk_bf16(s[0 * 33], s[1 * 33]); o.y = cvt_pk_bf16(s[2 * 33], s[3 * 33]); o.z = cvt_pk_bf16(s[4 * 33], s[5 * 33]); o.w = cvt_pk_bf16(s[6 * 33], s[7 * 33]);
    const int orow = G1PERM ? pg8::g1_row(n0 + n) : (n0 + n);
    *(u32x4*)(WT + (size_t)(row_off + orow) * dpitch + coff + k0 + 8 * c) = o; }
  asm volatile("s_waitcnt lgkmcnt(0)" ::: "memory");
}

__global__ void __launch_bounds__(512) mega_fwd(Params p) {
  extern __shared__ __attribute__((aligned(16))) unsigned char lds_raw[];
  LAS unsigned char* lds = (LAS unsigned char*)lds_raw;
  cg::grid_group grid = cg::this_grid();
  const int G = gridDim.x, cb = blockIdx.x, NGW = G * 8;
#define PHASE_IDS int tid = threadIdx.x; asm volatile("" : "+v"(tid)); const int lane = tid & 63, wave = __builtin_amdgcn_readfirstlane(tid >> 6), gw = cb * 8 + wave; (void)lane; (void)gw;
  unsigned char* ws = p.ws;
  bf16_t* WT1 = (bf16_t*)(ws + WS_WT1); bf16_t* WT2 = (bf16_t*)(ws + WS_WT2); bf16_t* WT3 = (bf16_t*)(ws + WS_WT3);
  bf16_t* HB = (bf16_t*)(ws + WS_H); bf16_t* YB = HB; bf16_t* QKVG = (bf16_t*)(ws + WS_QKVG); bf16_t* MERGED = QKVG; bf16_t* MG = (bf16_t*)(ws + WS_MG);
  bf16_t* PO = (bf16_t*)(ws + WS_PO); float* PLSE = (float*)(ws + WS_PLSE); float* ADA = (float*)(ws + WS_ADA);

  for (int rep = 0; rep < REPS(4); ++rep) {
    PHASE_IDS
    __syncthreads();
    LAS float* sc = (LAS float*)lds; LAS float* red = (LAS float*)(lds + 16384);
    for (int i = tid; i < NB * DM; i += 512) { const float v = p.c[i]; sc[i] = v * sigmoidf_(v); }
    __syncthreads();
    for (int u = cb; u < DEPTH * 96; u += G) {
      const int l = u / 96, jb = u % 96, col = jb * 64 + lane;
      const float* W = p.w_ada + (size_t)l * DM * (3 * DM) + col;
      float a0 = 0.f, a1 = 0.f; const int k0 = wave * 256;
#pragma unroll 8
      for (int k = 0; k < 256; ++k) { const float w = W[(size_t)(k0 + k) * (3 * DM)]; a0 += sc[k0 + k] * w; a1 += sc[DM + k0 + k] * w; }
      red[(wave * 2 + 0) * 64 + lane] = a0; red[(wave * 2 + 1) * 64 + lane] = a1;
      __syncthreads();
      if (tid < 128) { const int b = tid >> 6, cc = tid & 63; float s = 0.f;
#pragma unroll
        for (int w = 0; w < 8; ++w) s += red[(w * 2 + b) * 64 + cc];
        ADA[(size_t)(l * NB + b) * (3 * DM) + jb * 64 + cc] = s + p.b_ada[l * 3 * DM + jb * 64 + cc]; }
      __syncthreads();
    }
    __syncthreads();
    LAS float* scr = (LAS float*)(lds + wave * 16384);
    constexpr int I_IN = 32 * (INC / 32), I_GM = 32 * (GMC / 32), I_BR = 4 * 8 * 64, I_OUT = 32 * 64, I_L = I_IN + I_GM + I_BR + I_OUT;
    for (int it = gw; it < DEPTH * I_L; it += NGW) {
      const int l = it / I_L; int r = it % I_L;
      if (r < I_IN) { transpose_item<true>(p.w_in + (size_t)l * DM * INC, INC, WT1 + (size_t)l * N1 * DM, DM, 0, 0, scr, r, lane); continue; } r -= I_IN;
      if (r < I_GM) { transpose_item<false>(p.w_gm + (size_t)l * DM * GMC, GMC, WT1 + (size_t)l * N1 * DM, DM, INC, 0, scr, r, lane); continue; } r -= I_GM;
      if (r < I_BR) { const int n = r / 512; transpose_item<false>(p.w_branch + (size_t)(l * 4 + n) * 512 * DM, DM, WT2 + (size_t)l * DM * DM, DM, 0, n * 512, scr, r % 512, lane); continue; } r -= I_BR;
      transpose_item<false>(p.w_out + (size_t)l * DM * DM, DM, WT3 + (size_t)l * DM * DM, DM, 0, 0, scr, r, lane);
    }
  }
  GSYNC();

#pragma unroll 1
  for (int l = 0; l < DEPTH; ++l) {
    const float* xin = (l == 0) ? p.x : p.out;
    for (int rep = 0; rep < REPS(4); ++rep) { PHASE_IDS
    for (int row = gw; row < NTOK; row += NGW) {
      const int b = row >> 13;
      const f32x4* xr = (const f32x4*)(xin + (size_t)row * DM) + lane;
      f32x4 v[8]; float ss = 0.f;
#pragma unroll
      for (int j = 0; j < 8; ++j) { v[j] = xr[64 * j]; ss += (v[j].x * v[j].x + v[j].y * v[j].y) + (v[j].z * v[j].z + v[j].w * v[j].w); }
      const float rstd = rsqrtf(wave_sum(ss) * (1.f / DM) + EPS);
      const float* ad = ADA + (size_t)(l * NB + b) * (3 * DM);
      u32x2* o8 = (u32x2*)(HB + (size_t)row * DM) + lane;
#pragma unroll
      for (int j = 0; j < 8; ++j) { const int col = (64 * j + lane) * 4;
        const f32x4 g = *(const f32x4*)(p.norm_g + l * DM + col), sh = *(const f32x4*)(ad + col), scl = *(const f32x4*)(ad + DM + col);
        const f32x4 y = (v[j] * rstd * g) * (scl + 1.0f) + sh;
        u32x2 w; w.x = cvt_pk_bf16(y.x, y.y); w.y = cvt_pk_bf16(y.z, y.w); o8[64 * j] = w; }
    } }
    GSYNC();
#if PH_G1
    for (int rep = 0; rep < REPS(2); ++rep) { pg8::Gemm g{HB, WT1 + (size_t)l * N1 * DM, DM, DM}; pg8::Order S; S.init(NTOK, N1, G, cb, 0);
      pg8::EpiG1 E{QKVG, MG}; pg8::gemm_phase<pg8::EpiG1>(lds, g, S, E); }
#endif
    GSYNC();
    for (int rep = 0; rep < REPS(3); ++rep) { PHASE_IDS
    for (int it0 = gw; it0 < NTOK * 2; it0 += 4 * NGW) {
      const int l16 = lane & 15, sub = lane >> 4;
      int e0; const float* inv;
      if (l16 < 8) { e0 = 4 * l16; inv = INV32 + e0; } else { e0 = 64 + 4 * (l16 - 8); inv = INV32 + (e0 - 64); }
      const f32x4 iv = *(const f32x4*)inv;
      u32x2 ra[4], rb[4]; bf16_t* bp[4]; bool act[4];
#pragma unroll
      for (int k = 0; k < 4; ++k) { const int it = it0 + k * NGW; const int tok = it >> 1, isk = it & 1;
        act[k] = (it < NTOK * 2) && (isk == 0 || sub < 2);
        bp[k] = QKVG + (size_t)(act[k] ? tok : 0) * INC + (isk ? KC : QC) + (act[k] ? sub : 0) * 128 + e0;
        ra[k] = *(const u32x2*)bp[k]; rb[k] = *(const u32x2*)(bp[k] + 32); }
#pragma unroll
      for (int k = 0; k < 4; ++k) { const int it = it0 + k * NGW; const int tok = it >> 1, isk = it & 1, s = tok & (SEQ - 1);
        const float pos = (l16 < 8) ? (float)(s >> 6) : (float)(s & 63);
        float a[4] = {bf_lo(ra[k].x), bf_hi(ra[k].x), bf_lo(ra[k].y), bf_hi(ra[k].y)}, b[4] = {bf_lo(rb[k].x), bf_hi(rb[k].x), bf_lo(rb[k].y), bf_hi(rb[k].y)};
        float ss = (a[0] * a[0] + a[1] * a[1]) + (a[2] * a[2] + a[3] * a[3]) + (b[0] * b[0] + b[1] * b[1]) + (b[2] * b[2] + b[3] * b[3]);
        ss += __shfl_xor(ss, 1); ss += __shfl_xor(ss, 2); ss += __shfl_xor(ss, 4); ss += __shfl_xor(ss, 8);
        const float rstd = rsqrtf(ss * (1.f / 128.f) + EPS); const float* wn = (isk ? p.c_k_norm : p.c_q_norm) + l * 128 + e0;
        const f32x4 wa_ = *(const f32x4*)wn, wb_ = *(const f32x4*)(wn + 32);
        float oa[4], ob[4];
#pragma unroll
        for (int j = 0; j < 4; ++j) { const float av = a[j] * rstd * wa_[j], bv = b[j] * rstd * wb_[j];
          const float ang = pos * iv[j]; double rev = (double)ang * 0.15915494309189535; rev -= __builtin_rint(rev);
          const float fr = (float)rev, sn = __builtin_amdgcn_sinf(fr), cs = __builtin_amdgcn_cosf(fr);
          oa[j] = av * cs - bv * sn; ob[j] = bv * cs + av * sn; }
        u32x2 wa, wb; wa.x = cvt_pk_bf16(oa[0], oa[1]); wa.y = cvt_pk_bf16(oa[2], oa[3]); wb.x = cvt_pk_bf16(ob[0], ob[1]); wb.y = cvt_pk_bf16(ob[2], ob[3]);
        if (act[k]) { *(u32x2*)bp[k] = wa; *(u32x2*)(bp[k] + 32) = wb; } }
    }
    for (int u = cb; u < 1280; u += G) {
#if PH_A
      if (u < 256) {
        const int b = u >> 7, hq = (u >> 5) & 3, qb = u & 31, q0 = qb * 256;
        int lo = q0 - 128; if (lo < 0) lo = 0; int hi = q0 + 384; if (hi > SEQ) hi = SEQ;
        const size_t t0 = (size_t)b * SEQ + q0, k0 = (size_t)b * SEQ + lo;
        att::MaskBand mk{lo - q0, 128}; att::OutGated og{YB + t0 * DM + 0 * 512 + hq * 128, QKVG + t0 * INC + GA + hq * 128};
        att::attn_unit(QKVG + t0 * INC + QA + hq * 128, QKVG + k0 * INC + KA + (hq >> 1) * 128, QKVG + k0 * INC + VA + (hq >> 1) * 128, INC, INC, (hi - lo) >> 6,
                       p.a_sink[l * 4 + hq] * (1.0f / att::SCALE), 1.0f, mk, og, (LAS char*)lds);
      } else
#endif
#if PH_B
      if (u >= 256 && u < 1024) {
        const int v = u - 256, pt = v >> 8, b = (v >> 7) & 1, h = (v >> 5) & 3, blk = v & 31;
        const int dsh = 2 * pt, dil = 1 << dsh, L = SEQ >> dsh, bpr = L >> 8;
        const int r = blk / bpr, lb = blk % bpr, l0 = lb * 256;
        int lo = l0 - 64; if (lo < 0) lo = 0; int hi = l0 + 320; if (hi > L) hi = L;
        if (((hi - lo) >> 6) & 1) { if (lo == 0) hi += 64; else lo -= 64; }
        const size_t t0 = (size_t)b * SEQ + r + (size_t)dil * l0, k0 = (size_t)b * SEQ + r + (size_t)dil * lo;
        att::MaskBand mk{lo - l0, 64}; att::OutPartial op{PO + ((size_t)pt * NTOK + t0) * 512 + h * 128, PLSE + ((size_t)pt * NTOK + t0) * 4 + h, dil};
        att::attn_unit(QKVG + t0 * INC + QB_ + h * 128, QKVG + k0 * INC + KB_ + h * 128, QKVG + k0 * INC + VB_ + h * 128, INC * dil, INC * dil, (hi - lo) >> 6,
                       att::MFLOOR, 0.0f, mk, op, (LAS char*)lds);
      } else
#endif
#if PH_D
      if (u >= 1024) {
        const int v = u - 1024, b = v >> 7, h = (v >> 5) & 3, blk = v & 31, r0 = blk * 4;
        int lo = r0 - 4; lo = lo < 0 ? 0 : (lo > 120 ? 120 : lo); int hi = r0 + 3 - 4; hi = (hi < 0 ? 0 : (hi > 120 ? 120 : hi)) + 8;
        if ((hi - lo) & 1) { if (hi < 128) hi += 1; else lo -= 1; }
        LAS float* tab = (LAS float*)(lds + att::TAB_OFF);
        __syncthreads();
        for (int i = tid; i < 15 * 128; i += 512) { const int dr = i >> 7, dc = (i & 127) - 63;
          tab[i] = (dc >= -15 && dc <= 15) ? p.d_rel_bias[(size_t)(l * 4 + h) * 465 + dr * 31 + dc + 15] * (1.0f / att::SCALE) : 0.f; }
        __syncthreads();
        const size_t t0 = (size_t)b * SEQ + r0 * 64, k0 = (size_t)b * SEQ + lo * 64;
        att::MaskNA mk{r0, lo, tab}; att::OutGated og{YB + t0 * DM + 3 * 512 + h * 128, QKVG + t0 * INC + GD + h * 128};
        att::attn_unit<att::MaskNA, att::OutGated, 1>(QKVG + t0 * INC + QD + h * 128, QKVG + k0 * INC + KD + h * 128, QKVG + k0 * INC + VD + h * 128, INC, INC, hi - lo,
                       att::MFLOOR, 0.0f, mk, og, (LAS char*)lds);
      }
#endif
      {}
    } }
    GSYNC();
    for (int rep = 0; rep < REPS(4); ++rep) { PHASE_IDS
    for (int tok = gw; tok < NTOK; tok += NGW) {
      const int h = lane >> 4, c8 = (lane & 15) * 8;
      const float l0 = PLSE[((size_t)0 * NTOK + tok) * 4 + h], l1 = PLSE[((size_t)1 * NTOK + tok) * 4 + h], l2 = PLSE[((size_t)2 * NTOK + tok) * 4 + h];
      const float mx = fmaxf(l0, fmaxf(l1, l2)); float w0 = __expf(l0 - mx), w1 = __expf(l1 - mx), w2 = __expf(l2 - mx); const float rs = 1.0f / (w0 + w1 + w2); w0 *= rs; w1 *= rs; w2 *= rs;
      const u32x4 o0 = *(const u32x4*)(PO + ((size_t)0 * NTOK + tok) * 512 + h * 128 + c8), o1 = *(const u32x4*)(PO + ((size_t)1 * NTOK + tok) * 512 + h * 128 + c8), o2 = *(const u32x4*)(PO + ((size_t)2 * NTOK + tok) * 512 + h * 128 + c8);
      const u32x4 gg = *(const u32x4*)(QKVG + (size_t)tok * INC + GB_ + h * 128 + c8);
      u32x4 y;
#define CMB(F) cvt_pk_bf16((w0 * bf_lo(o0.F) + w1 * bf_lo(o1.F) + w2 * bf_lo(o2.F)) * bf_lo(gg.F), (w0 * bf_hi(o0.F) + w1 * bf_hi(o1.F) + w2 * bf_hi(o2.F)) * bf_hi(gg.F))
      y.x = CMB(x); y.y = CMB(y); y.z = CMB(z); y.w = CMB(w);
#undef CMB
      *(u32x4*)(YB + (size_t)tok * DM + 1 * 512 + h * 128 + c8) = y;
    } }
#if PH_C
    for (int rep = 0; rep < REPS(3) * REPS(6); ++rep)
    for (int u = cb; u < 256; u += G) {
      const int xcd = u & 7, idx = u >> 3, pair = xcd >> 1, b = pair >> 1, kvh = pair & 1, hq = kvh * 2 + (xcd & 1), q0 = idx * 256;
      const size_t t0 = (size_t)b * SEQ + q0, k0 = (size_t)b * SEQ;
      att::MaskNone mk; att::OutGated og{YB + t0 * DM + 2 * 512 + hq * 128, QKVG + t0 * INC + GC + hq * 128};
      att::attn_unit(QKVG + t0 * INC + QC + hq * 128, QKVG + k0 * INC + KC + kvh * 128, QKVG + k0 * INC + VC + kvh * 128, INC, INC, SEQ / 64,
                     att::MFLOOR, 0.0f, mk, og, (LAS char*)lds);
    }
#endif
    GSYNC();
#if PH_G2
    for (int rep = 0; rep < REPS(5); ++rep) { pg8::Gemm g{YB, WT2 + (size_t)l * DM * DM, DM, 512}; pg8::Order S; S.init(NTOK, DM, G, cb, 2);
      pg8::EpiG2 E{MG, MERGED}; pg8::gemm_phase<pg8::EpiG2>(lds, g, S, E); }
#endif
    GSYNC();
#if PH_G3
    for (int rep = 0; rep < REPS(7); ++rep) { pg8::Gemm g{MERGED, WT3 + (size_t)l * DM * DM, DM, DM}; pg8::Order S; S.init(NTOK, DM, G, cb, 0);
      pg8::EpiG3 E{xin, (PROBE == 7 && rep == 0) ? (float*)MG : p.out, ADA + (size_t)(l * NB) * (3 * DM) + 2 * DM}; pg8::gemm_phase<pg8::EpiG3>(lds, g, S, E); }
#endif
    GSYNC();
  }
  { PHASE_IDS
  for (int row = gw; row < NTOK; row += NGW) {
    f32x4* xr = (f32x4*)(p.out + (size_t)row * DM) + lane;
    f32x4 v[8]; float ss = 0.f;
#pragma unroll
    for (int j = 0; j < 8; ++j) { v[j] = xr[64 * j]; ss += (v[j].x * v[j].x + v[j].y * v[j].y) + (v[j].z * v[j].z + v[j].w * v[j].w); }
    const float rstd = rsqrtf(wave_sum(ss) * (1.f / DM) + EPS);
#pragma unroll
    for (int j = 0; j < 8; ++j) { const f32x4 g = *(const f32x4*)(p.final_g + (64 * j + lane) * 4); xr[64 * j] = v[j] * rstd * g; }
  } }
}

extern "C" void kernel_launch(void* const* d_in, const int* in_sizes, int n_in, void* d_out, int out_size, void* d_ws, size_t ws_size, hipStream_t stream) {
  static int grid_blocks = 0;
  if (grid_blocks == 0) {
    if (n_in != 14 || out_size != NTOK * DM || ws_size < WS_END) { fprintf(stderr, "kernel_launch: unexpected shapes (n_in %d out %d ws %zu need %zu)\n", n_in, out_size, ws_size, (size_t)WS_END); grid_blocks = -1; return; }
    int dev = 0, cus = 0, per_cu = 0;
    hipGetDevice(&dev); hipDeviceGetAttribute(&cus, hipDeviceAttributeMultiprocessorCount, dev);
    if (hipFuncSetAttribute((const void*)mega_fwd, hipFuncAttributeMaxDynamicSharedMemorySize, LDS_BYTES) != hipSuccess) { fprintf(stderr, "kernel_launch: hipFuncSetAttribute failed\n"); grid_blocks = -1; return; }
    hipOccupancyMaxActiveBlocksPerMultiprocessor(&per_cu, (const void*)mega_fwd, 512, LDS_BYTES);
    (void)hipGetLastError();
    if (per_cu < 1) per_cu = 1;
    grid_blocks = cus * 1;
  }
  if (grid_blocks < 0) return;
  Params p{};
  p.x = (const float*)d_in[0]; p.c = (const float*)d_in[1]; p.norm_g = (const float*)d_in[2]; p.w_ada = (const float*)d_in[3]; p.b_ada = (const float*)d_in[4];
  p.w_in = (const float*)d_in[5]; p.a_sink = (const float*)d_in[6]; p.c_q_norm = (const float*)d_in[7]; p.c_k_norm = (const float*)d_in[8]; p.d_rel_bias = (const float*)d_in[9];
  p.w_gm = (const float*)d_in[10]; p.w_branch = (const float*)d_in[11]; p.w_out = (const float*)d_in[12]; p.final_g = (const float*)d_in[13];
  p.out = (float*)d_out; p.ws = (unsigned char*)d_ws;
  void* args[] = {&p};
  hipError_t e = hipLaunchCooperativeKernel((const void*)mega_fwd, dim3(grid_blocks), dim3(512), args, LDS_BYTES, stream);
  if (e != hipSuccess) fprintf(stderr, "cooperative launch failed: %s (grid %d)\n", hipGetErrorString(e), grid_blocks);
}
```

```cpp
#include <hip/hip_runtime.h>
#include <hip/hip_bf16.h>
#include <hip/hip_cooperative_groups.h>
#include <cstdio>
#include <cstdint>
#include <cmath>
namespace cg = cooperative_groups;

#define LAS __attribute__((address_space(3)))
typedef unsigned short bf16_t;
typedef short bf16x8 __attribute__((ext_vector_type(8)));
typedef short s16x4 __attribute__((ext_vector_type(4)));
typedef float f32x4 __attribute__((ext_vector_type(4)));
typedef float f32x2 __attribute__((ext_vector_type(2)));
typedef float f32x16 __attribute__((ext_vector_type(16)));
typedef unsigned u32x4 __attribute__((ext_vector_type(4)));
typedef unsigned u32x2 __attribute__((ext_vector_type(2)));

__constant__ float INV64[64] = {1.000000000e+00f, 8.659643531e-01f, 7.498942018e-01f, 6.493816376e-01f, 5.623413324e-01f, 4.869675338e-01f, 4.216965139e-01f, 3.651741147e-01f, 3.162277639e-01f, 2.738419771e-01f, 2.371373773e-01f, 2.053525001e-01f, 1.778279394e-01f, 1.539926529e-01f, 1.333521456e-01f, 1.154781953e-01f, 1.000000015e-01f, 8.659642935e-02f, 7.498942316e-02f, 6.493816525e-02f, 5.623413250e-02f, 4.869675264e-02f, 4.216964915e-02f, 3.651741147e-02f, 3.162277490e-02f, 2.738419548e-02f, 2.371373773e-02f, 2.053525113e-02f, 1.778279431e-02f, 1.539926510e-02f, 1.333521400e-02f, 1.154781971e-02f, 9.999999776e-03f, 8.659643121e-03f, 7.498942316e-03f, 6.493816152e-03f, 5.623413250e-03f, 4.869675264e-03f, 4.216964822e-03f, 3.651741194e-03f, 3.162277630e-03f, 2.738419687e-03f, 2.371373819e-03f, 2.053525066e-03f, 1.778279431e-03f, 1.539926510e-03f, 1.333521446e-03f, 1.154782018e-03f, 1.000000047e-03f, 8.659643354e-04f, 7.498941850e-04f, 6.493816036e-04f, 5.623413017e-04f, 4.869675322e-04f, 4.216965172e-04f, 3.651741135e-04f, 3.162277571e-04f, 2.738419571e-04f, 2.371373703e-04f, 2.053525095e-04f, 1.778279402e-04f, 1.539926598e-04f, 1.333521504e-04f, 1.154782003e-04f};
__constant__ float INV32[32] = {1.000000000e+00f, 7.498942018e-01f, 5.623413324e-01f, 4.216965139e-01f, 3.162277639e-01f, 2.371373773e-01f, 1.778279394e-01f, 1.333521456e-01f, 1.000000015e-01f, 7.498942316e-02f, 5.623413250e-02f, 4.216964915e-02f, 3.162277490e-02f, 2.371373773e-02f, 1.778279431e-02f, 1.333521400e-02f, 9.999999776e-03f, 7.498942316e-03f, 5.623413250e-03f, 4.216964822e-03f, 3.162277630e-03f, 2.371373819e-03f, 1.778279431e-03f, 1.333521446e-03f, 1.000000047e-03f, 7.498941850e-04f, 5.623413017e-04f, 4.216965172e-04f, 3.162277571e-04f, 2.371373703e-04f, 1.778279402e-04f, 1.333521504e-04f};

constexpr int DM = 2048, SEQ = 8192, NB = 2, NTOK = NB * SEQ, DEPTH = 4;
constexpr int INC = 7168, GMC = 8192, N1 = INC + GMC;
constexpr float EPS = 1e-6f;
constexpr int QA = 0, KA = 512, VA = 768, GA = 1024, QB_ = 1536, KB_ = 2048, VB_ = 2560, GB_ = 3072, QC = 3584, KC = 4096, VC = 4352, GC = 4608, QD = 5120, KD = 5632, VD = 6144, GD = 6656;

constexpr size_t WS_WT1 = 0;
constexpr size_t WS_WT2 = WS_WT1 + (size_t)DEPTH * N1 * DM * 2;
constexpr size_t WS_WT3 = WS_WT2 + (size_t)DEPTH * DM * DM * 2;
constexpr size_t WS_H = WS_WT3 + (size_t)DEPTH * DM * DM * 2;
constexpr size_t WS_QKVG = WS_H + (size_t)NTOK * DM * 2;
constexpr size_t WS_MG = WS_QKVG + (size_t)NTOK * INC * 2;
constexpr size_t WS_PO = WS_MG + (size_t)NTOK * GMC * 2;
constexpr size_t WS_PLSE = WS_PO + (size_t)3 * NTOK * 512 * 2;
constexpr size_t WS_ADA = WS_PLSE + (size_t)3 * NTOK * 4 * 4;
constexpr size_t WS_BAR = WS_ADA + (size_t)DEPTH * NB * 3 * DM * 4;
constexpr size_t WS_END = WS_BAR + 16384;

__device__ __forceinline__ unsigned cvt_pk_bf16(float lo, float hi) { unsigned r; asm volatile("v_cvt_pk_bf16_f32 %0, %1, %2" : "=v"(r) : "v"(lo), "v"(hi)); return r; }
__device__ __forceinline__ float bf_lo(unsigned w) { return __uint_as_float(w << 16); }
__device__ __forceinline__ float bf_hi(unsigned w) { return __uint_as_float(w & 0xffff0000u); }
__device__ __forceinline__ float bf2f(bf16_t v) { return __uint_as_float(((unsigned)v) << 16); }
__device__ __forceinline__ bf16_t f2bf(float f) { return (bf16_t)(cvt_pk_bf16(f, 0.f) & 0xffffu); }
__device__ __forceinline__ float sigmoidf_(float v) { return __builtin_amdgcn_rcpf(1.0f + __expf(-v)); }

namespace pg8 {
constexpr int BM = 256, BK = 64, HALF = 128, HTB = HALF * BK * 2, STAGE_BYTES = 8 * HTB, NXCD = 8, WGM = 8;
__host__ __device__ __forceinline__ int lds_byte(int r, int c) { const int st = (r >> 4) * 2 + (c >> 5), rr = r & 15, cc = c & 31, ob = rr * 64 + cc * 2; return st * 1024 + (ob ^ (((ob >> 9) & 1) << 5)); }
__host__ __device__ __forceinline__ void stage_rc(int b, int& R, int& C) { const int st = b / 1024, sb = b % 1024, swz = sb ^ (((sb >> 9) & 1) << 5); R = (st >> 1) * 16 + swz / 64; C = (st & 1) * 32 + (swz % 64) / 2; }
__host__ __device__ __forceinline__ int perm32(int rho) { const int n = rho >> 4, i = rho & 15; return 8 * (i >> 2) + 4 * n + (i & 3); }

struct Unit { int pm, pn, seg; };
struct Gemm { const bf16_t* A; const bf16_t* Bt; int ld; int kseg; };

struct Order {
    int nM, nN, nwg, G, c, segshift;
    __device__ void init(int M, int N, int G_, int c_, int segshift_) { nM = M / BM; nN = N / BM; nwg = nM * nN; G = G_; c = c_; segshift = segshift_; }
    __device__ bool next(int i, Unit& u) const {
        const long L = (long)(i >> segshift) * G + c; if (L >= nwg) return false;
        int wgid = (int)L; { const int q = nwg / NXCD, r = nwg % NXCD, xcd = wgid % NXCD, off = wgid / NXCD; wgid = (xcd < r ? xcd * (q + 1) : r * (q + 1) + (xcd - r) * q) + off; }
        const int nig = WGM * nN, gid = wgid / nig, fm = gid * WGM, gsz = (nM - fm) < WGM ? (nM - fm) : WGM;
        u.pm = fm + ((wgid % nig) % gsz); u.pn = (wgid % nig) / gsz; u.seg = i & ((1 << segshift) - 1); return true;
    }
};


__host__ __device__ __forceinline__ int g1_row(int n) {
    const bool rope = (n < 768) || (n >= 1536 && n < 2560);
    if (!rope) return n;
    const int hb = n & ~127, d = n & 127, dd = d & 63;
    return hb + 8 * (dd >> 2) + (dd & 3) + ((d >> 6) << 2);
}
struct EpiG1 {
    static constexpr bool PERM = true;
    bf16_t* qkvg; bf16_t* mg;
    __device__ __forceinline__ bool zero_after(const Unit&) const { return true; }
    __device__ __forceinline__ void operator()(f32x4 (&acc)[2][2][4][2], const Unit& u, int wr, int wc, int fr, int fq) const {
        const int row0 = u.pm * BM + wr * 64 + fr; const int pn = u.pn;
        if (pn <= 2 || (pn >= 6 && pn <= 9)) {
            const int g4 = (4 * wc + fq) * 4;
            const f32x4 inv = *(const f32x4*)(INV64 + g4);
#pragma unroll
            for (int ai = 0; ai < 2; ++ai)
#pragma unroll
                for (int m = 0; m < 4; ++m) { const int row = row0 + ai * HALF + m * 16; const float pos = (float)(row & (SEQ - 1));
                    bf16_t* rowp = qkvg + (size_t)row * INC + pn * BM + g4;
                    f32x4 cs, sn;
#pragma unroll
                    for (int e = 0; e < 4; ++e) { const float ang = pos * inv[e]; double rev = (double)ang * 0.15915494309189535; rev -= __builtin_rint(rev);
                        const float fr_ = (float)rev; sn[e] = __builtin_amdgcn_sinf(fr_); cs[e] = __builtin_amdgcn_cosf(fr_); }
#pragma unroll
                    for (int bj = 0; bj < 2; ++bj) { const f32x4 a = acc[ai][bj][m][0], b = acc[ai][bj][m][1];
                        const f32x4 oa = a * cs - b * sn, ob = b * cs + a * sn;
                        u32x2 wa, wb; wa.x = cvt_pk_bf16(oa[0], oa[1]); wa.y = cvt_pk_bf16(oa[2], oa[3]); wb.x = cvt_pk_bf16(ob[0], ob[1]); wb.y = cvt_pk_bf16(ob[2], ob[3]);
                        *(u32x2*)(rowp + bj * HALF) = wa; *(u32x2*)(rowp + bj * HALF + 64) = wb; } }
            return;
        }
        int mode, ldc, colt; bf16_t* base;
        if (pn < 28) { base = qkvg; ldc = INC; colt = pn * BM; mode = (pn == 4 || pn == 5 || pn == 12 || pn == 13 || pn == 18 || pn == 19 || pn == 26 || pn == 27) ? 1 : 0; }
        else { base = mg; ldc = GMC; colt = (pn - 28) * BM; mode = 2; }
        const int col0 = colt + wc * 32 + 8 * fq;
#pragma unroll
        for (int ai = 0; ai < 2; ++ai)
#pragma unroll
            for (int m = 0; m < 4; ++m) { bf16_t* rowp = base + (size_t)(row0 + ai * HALF + m * 16) * ldc + col0;
#pragma unroll
                for (int bj = 0; bj < 2; ++bj) { f32x4 v0 = acc[ai][bj][m][0], v1 = acc[ai][bj][m][1];
                    if (mode != 0) {
#pragma unroll
                        for (int e = 0; e < 4; ++e) { const float s0 = sigmoidf_(v0[e]), s1 = sigmoidf_(v1[e]); v0[e] = (mode == 1) ? v0[e] * s0 : s0; v1[e] = (mode == 1) ? v1[e] * s1 : s1; }
                    }
                    u32x4 w; w.x = cvt_pk_bf16(v0[0], v0[1]); w.y = cvt_pk_bf16(v0[2], v0[3]); w.z = cvt_pk_bf16(v1[0], v1[1]); w.w = cvt_pk_bf16(v1[2], v1[3]);
                    *(u32x4*)(rowp + bj * HALF) = w; } }
    }
};
struct EpiG2 {
    static constexpr bool PERM = true;
    const bf16_t* mg; bf16_t* out;
    __device__ __forceinline__ bool zero_after(const Unit& u) const { return u.seg == 3; }
    __device__ __forceinline__ void operator()(f32x4 (&acc)[2][2][4][2], const Unit& u, int wr, int wc, int fr, int fq) const {
        const int row0 = u.pm * BM + wr * 64 + fr, col0 = u.pn * BM + wc * 32 + 8 * fq, seg = u.seg;
#pragma unroll
        for (int ai = 0; ai < 2; ++ai)
#pragma unroll
            for (int m = 0; m < 4; ++m) { const int row = row0 + ai * HALF + m * 16; const bf16_t* gp = mg + (size_t)row * GMC + seg * DM + col0;
#pragma unroll
                for (int bj = 0; bj < 2; ++bj) {
                    const u32x4 ga = *(const u32x4*)(gp + bj * HALF);
                    float f[8] = {bf_lo(ga.x), bf_hi(ga.x), bf_lo(ga.y), bf_hi(ga.y), bf_lo(ga.z), bf_hi(ga.z), bf_lo(ga.w), bf_hi(ga.w)};
                    if (seg < 3) { const u32x4 gb = *(const u32x4*)(gp + DM + bj * HALF);
                        const float d[8] = {bf_lo(gb.x), bf_hi(gb.x), bf_lo(gb.y), bf_hi(gb.y), bf_lo(gb.z), bf_hi(gb.z), bf_lo(gb.w), bf_hi(gb.w)};
#pragma unroll
                        for (int e = 0; e < 8; ++e) f[e] = f[e] * __builtin_amdgcn_rcpf(d[e]); }
                    f32x4 v0 = acc[ai][bj][m][0], v1 = acc[ai][bj][m][1];
                    v0[0] *= f[0]; v0[1] *= f[1]; v0[2] *= f[2]; v0[3] *= f[3]; v1[0] *= f[4]; v1[1] *= f[5]; v1[2] *= f[6]; v1[3] *= f[7];
                    acc[ai][bj][m][0] = v0; acc[ai][bj][m][1] = v1;
                    if (seg == 3) { u32x4 w; w.x = cvt_pk_bf16(v0[0], v0[1]); w.y = cvt_pk_bf16(v0[2], v0[3]); w.z = cvt_pk_bf16(v1[0], v1[1]); w.w = cvt_pk_bf16(v1[2], v1[3]);
                        *(u32x4*)(out + (size_t)row * DM + col0 + bj * HALF) = w; } } }
    }
};
struct EpiG3 {
    static constexpr bool PERM = false;
    const float* xin; float* xout; const float* gate;
    __device__ __forceinline__ bool zero_after(const Unit&) const { return true; }
    __device__ __forceinline__ void operator()(f32x4 (&acc)[2][2][4][2], const Unit& u, int wr, int wc, int fr, int fq) const {
        const int col0 = u.pn * BM + wc * 32 + 4 * fq;
        const float* gp = gate + (size_t)((u.pm * BM) >> 13) * (3 * DM) + col0;
        f32x4 gv[2][2];
#pragma unroll
        for (int bj = 0; bj < 2; ++bj)
#pragma unroll
            for (int n = 0; n < 2; ++n) gv[bj][n] = *(const f32x4*)(gp + bj * HALF + n * 16);
#pragma unroll
        for (int ai = 0; ai < 2; ++ai)
#pragma unroll
            for (int m = 0; m < 4; ++m) { const size_t off = (size_t)(u.pm * BM + ai * HALF + wr * 64 + m * 16 + fr) * DM + col0;
#pragma unroll
                for (int bj = 0; bj < 2; ++bj)
#pragma unroll
                    for (int n = 0; n < 2; ++n) { const f32x4 xo = *(const f32x4*)(xin + off + bj * HALF + n * 16);
                        *(f32x4*)(xout + off + bj * HALF + n * 16) = xo + gv[bj][n] * acc[ai][bj][m][n]; }
                if (m & 1) asm volatile("" ::: "memory"); }
    }
};

template <class Epi>
__device__ __forceinline__ void gemm_phase(LAS unsigned char* lds, const Gemm g, const Order& S, const Epi& E) {
    int tid = threadIdx.x; asm volatile("" : "+v"(tid));
    const int wid = __builtin_amdgcn_readfirstlane(tid >> 6), lane = tid & 63, wr = wid >> 2, wc = wid & 3, fr = lane & 15, fq = lane >> 4;
    const int K = g.ld, nt = g.kseg / BK;
    unsigned voffA[2], voffB[2];
#pragma unroll
    for (int i = 0; i < 2; ++i) { int R, C; stage_rc(tid * 16 + i * 8192, R, C); const int Rb = Epi::PERM ? ((R & ~31) + perm32(R & 31)) : R;
        voffA[i] = (unsigned)(R * K + C) * 2u; voffB[i] = (unsigned)(Rb * K + C) * 2u; }
    const size_t kstep = (size_t)(BK * 2);
    const size_t hstep = (size_t)HALF * K * 2;
    const size_t tstep = 2 * hstep;
    const size_t sstep = (size_t)g.kseg * 2;
    const unsigned ldsw = (unsigned)wid * 1024u;
    const int aoff = lds_byte(wr * 64 + fr, fq * 8), boff = lds_byte(wc * 32 + fr, fq * 8);
#define PG8_SA(b, h) (((b) * 2 + (h)) * HTB)
#define PG8_SB(b, h) ((4 + (b) * 2 + (h)) * HTB)
#define PG8_STAGE(bufoff, gbase, voff) do { _Pragma("unroll") for (int _i = 0; _i < 2; ++_i) \
        __builtin_amdgcn_global_load_lds((const unsigned*)((const char*)(gbase) + (voff)[_i]), (LAS unsigned*)(lds + (bufoff) + ldsw + _i * 8192), 16, 0, 0); } while (0)
#define PG8_LDA(dst, b, h) do { _Pragma("unroll") for (int m = 0; m < 4; ++m) _Pragma("unroll") for (int k = 0; k < 2; ++k) dst[m][k] = *(const LAS bf16x8*)(lds + PG8_SA(b, h) + aoff + m * 2048 + k * 1024); } while (0)
#define PG8_LDB(dst, b, h) do { _Pragma("unroll") for (int n = 0; n < 2; ++n) _Pragma("unroll") for (int k = 0; k < 2; ++k) dst[n][k] = *(const LAS bf16x8*)(lds + PG8_SB(b, h) + boff + n * 2048 + k * 1024); } while (0)
#define PG8_MMA(ai, bj, At, Bt) do { __builtin_amdgcn_s_setprio(1); _Pragma("unroll") for (int m = 0; m < 4; ++m) _Pragma("unroll") for (int n = 0; n < 2; ++n) _Pragma("unroll") for (int k = 0; k < 2; ++k) \
        acc[ai][bj][m][n] = __builtin_amdgcn_mfma_f32_16x16x32_bf16(Bt[n][k], At[m][k], acc[ai][bj][m][n], 0, 0, 0); __builtin_amdgcn_s_setprio(0); } while (0)
#define PG8_WAIT_V(n) asm volatile("s_waitcnt vmcnt(" #n ")" ::: "memory")
#define PG8_WAIT_L(n) asm volatile("s_waitcnt lgkmcnt(" #n ")" ::: "memory")
#define PG8_BAR __builtin_amdgcn_s_barrier()
#define PG8_SCHED __builtin_amdgcn_sched_barrier(0)
#define PG8_UA(u) ((const char*)g.A + (size_t)(u).pm * tstep + (size_t)(u).seg * sstep)
#define PG8_UB(u) ((const char*)g.Bt + (size_t)(u).pn * tstep + (size_t)(u).seg * sstep)
    Unit cur, nxt; int ui = 0;
    if (!S.next(0, cur)) return;
    f32x4 acc[2][2][4][2];
#pragma unroll
    for (int a = 0; a < 2; ++a)
#pragma unroll
        for (int b = 0; b < 2; ++b)
#pragma unroll
            for (int m = 0; m < 4; ++m)
#pragma unroll
                for (int n = 0; n < 2; ++n) acc[a][b][m][n] = (f32x4){0.f, 0.f, 0.f, 0.f};
    bf16x8 At[4][2], B0[2][2], B1[2][2];
    const char* cA = PG8_UA(cur); const char* cB = PG8_UB(cur);
    PG8_STAGE(PG8_SB(0, 0), cB, voffB); PG8_STAGE(PG8_SB(0, 1), cB + hstep, voffB); PG8_STAGE(PG8_SA(0, 0), cA, voffA); PG8_STAGE(PG8_SA(0, 1), cA + hstep, voffA);
    if (wr == 1) PG8_BAR;
    PG8_WAIT_V(2); PG8_BAR;
    PG8_STAGE(PG8_SB(1, 0), cB + kstep, voffB); PG8_STAGE(PG8_SA(1, 0), cA + kstep, voffA); PG8_STAGE(PG8_SB(1, 1), cB + hstep + kstep, voffB);
    PG8_WAIT_V(6); PG8_BAR;
    for (;;) {
        const bool has_next = S.next(ui + 1, nxt);
        const char* nA = has_next ? PG8_UA(nxt) : cA; const char* nB = has_next ? PG8_UB(nxt) : cB;
        for (int t = 0; t < nt; t += 2) {
            const bool last = (t == nt - 2);
            const char* a1 = cA + (size_t)(t + 1) * kstep;
            const char* a2 = last ? nA : cA + (size_t)(t + 2) * kstep; const char* b2 = last ? nB : cB + (size_t)(t + 2) * kstep;
            const char* a3 = a2 + kstep; const char* b3 = b2 + kstep;
            PG8_LDB(B0, 0, 0); PG8_LDB(B1, 0, 1); PG8_SCHED; PG8_LDA(At, 0, 0); PG8_STAGE(PG8_SA(1, 1), a1 + hstep, voffA);
            PG8_WAIT_V(8); PG8_WAIT_L(0); PG8_BAR; PG8_MMA(0, 0, At, B0); PG8_MMA(0, 1, At, B1); PG8_BAR; PG8_SCHED;
            PG8_LDA(At, 0, 1); PG8_STAGE(PG8_SB(0, 0), b2, voffB); PG8_STAGE(PG8_SB(0, 1), b2 + hstep, voffB); PG8_STAGE(PG8_SA(0, 0), a2, voffA);
            PG8_WAIT_V(8); PG8_WAIT_L(0); PG8_BAR; PG8_MMA(1, 0, At, B0); PG8_MMA(1, 1, At, B1); PG8_BAR; PG8_SCHED;
            PG8_LDB(B0, 1, 0); PG8_LDB(B1, 1, 1); PG8_SCHED; PG8_LDA(At, 1, 0); PG8_STAGE(PG8_SA(0, 1), a2 + hstep, voffA);
            PG8_WAIT_V(8); PG8_WAIT_L(0); PG8_BAR; PG8_MMA(0, 0, At, B0); PG8_MMA(0, 1, At, B1); PG8_BAR; PG8_SCHED;
            PG8_LDA(At, 1, 1); PG8_STAGE(PG8_SB(1, 0), b3, voffB); PG8_STAGE(PG8_SB(1, 1), b3 + hstep, voffB); PG8_STAGE(PG8_SA(1, 0), a3, voffA);
            PG8_WAIT_V(8); PG8_WAIT_L(0); PG8_BAR; PG8_MMA(1, 0, At, B0); PG8_MMA(1, 1, At, B1); PG8_BAR; PG8_SCHED;
        }
        if (wr == 0) PG8_BAR;
        E(acc, cur, wr, wc, fr, fq);
        if (!has_next) break;
        if (E.zero_after(cur)) {
#pragma unroll
            for (int a = 0; a < 2; ++a)
#pragma unroll
                for (int b = 0; b < 2; ++b)
#pragma unroll
                    for (int m = 0; m < 4; ++m)
#pragma unroll
                        for (int n = 0; n < 2; ++n) acc[a][b][m][n] = (f32x4){0.f, 0.f, 0.f, 0.f};
        }
        cur = nxt; cA = nA; cB = nB; ++ui;
        if (wr == 1) PG8_BAR;
    }
    PG8_WAIT_V(0);
    PG8_BAR;
#undef PG8_SA
#undef PG8_SB
#undef PG8_STAGE
#undef PG8_LDA
#undef PG8_LDB
#undef PG8_MMA
#undef PG8_WAIT_V
#undef PG8_WAIT_L
#undef PG8_BAR
#undef PG8_SCHED
#undef PG8_UA
#undef PG8_UB
}
}

namespace att {
constexpr int D = 128, NW = 8, QBLK = 32, KVBLK = 64;
constexpr float SCALE = 0.088388347648318440f;
constexpr float THR = 8.f;
constexpr int SDEPTH = 2;
constexpr size_t SHM_V = KVBLK * D * 2, SHM_K = KVBLK * D * 2, SHM_ATTN = 2 * SHM_V + 2 * SHM_K + NW * 64 * 4;
constexpr float NEGBIG = -1e30f, MFLOOR = -30000.f;
#define KSWZ(row, colB) ((row) * 256 + ((colB) ^ (((row) & 7) << 4)))
#define SBAR() __builtin_amdgcn_sched_barrier(0)
__device__ __forceinline__ int sr_f(int tid) { return tid >> 4; }
__device__ __forceinline__ int crow(int r, int hi) { return (r & 3) + 8 * (r >> 2) + 4 * hi; }
__device__ __forceinline__ unsigned cvtpk(float lo, float hi) { unsigned r; asm volatile("v_cvt_pk_bf16_f32 %0, %1, %2" : "=v"(r) : "v"(lo), "v"(hi)); return r; }

__device__ __forceinline__ void partialSM(f32x16& p0, f32x16& p1, float& m_reg, float& mn, float& alpha) {
  constexpr float C = SCALE * 1.4426950408889634f;
  float pmax = p0[0]; for (int r = 1; r < 16; ++r) pmax = fmaxf(pmax, p0[r]); for (int r = 0; r < 16; ++r) pmax = fmaxf(pmax, p1[r]);
  { auto rr = __builtin_amdgcn_permlane32_swap(__float_as_uint(pmax), __float_as_uint(pmax), false, false);
    pmax = fmaxf(__uint_as_float(rr[0]), __uint_as_float(rr[1])); }
  if (__builtin_expect(__all(pmax - m_reg <= THR / SCALE), 1)) { mn = m_reg; alpha = 1.f; }
  else { mn = fmaxf(m_reg, pmax); alpha = __builtin_amdgcn_exp2f((m_reg - mn) * C); m_reg = mn; }
  float mnC = -mn * C;
  for (int r = 0; r < 16; ++r) p0[r] = fmaf(p0[r], C, mnC); for (int r = 0; r < 16; ++r) p1[r] = fmaf(p1[r], C, mnC);
  for (int r = 0; r < 16; ++r) p0[r] = __builtin_amdgcn_exp2f(p0[r]);
}
__device__ __forceinline__ void finishSM(f32x16& p0, f32x16& p1, float alpha, float& l_reg, bf16x8& pa0, bf16x8& pa1, bf16x8& pa2, bf16x8& pa3) {
  for (int r = 0; r < 16; ++r) p1[r] = __builtin_amdgcn_exp2f(p1[r]);
  float ps = 0; for (int r = 0; r < 16; ++r) ps += p0[r]; for (int r = 0; r < 16; ++r) ps += p1[r];
  { auto rr = __builtin_amdgcn_permlane32_swap(__float_as_uint(ps), __float_as_uint(ps), false, false);
    ps = __uint_as_float(rr[0]) + __uint_as_float(rr[1]); }
  l_reg = l_reg * alpha + ps;
#define PK4(P, BASE, OUT) do { unsigned a0 = cvtpk(P[BASE + 0], P[BASE + 1]), a1 = cvtpk(P[BASE + 2], P[BASE + 3]);   \
    unsigned b0 = cvtpk(P[BASE + 4], P[BASE + 5]), b1 = cvtpk(P[BASE + 6], P[BASE + 7]);                              \
    auto r0 = __builtin_amdgcn_permlane32_swap(a0, b0, false, false); auto r1 = __builtin_amdgcn_permlane32_swap(a1, b1, false, false); \
    u32x4 w = {r0[0], r1[0], r0[1], r1[1]}; OUT = *reinterpret_cast<bf16x8*>(&w); } while (0)
  PK4(p0, 0, pa0); PK4(p0, 8, pa1); PK4(p1, 0, pa2); PK4(p1, 8, pa3);
#undef PK4
}
__device__ __forceinline__ void qkt(f32x16& p0, f32x16& p1, const LAS char* Ks, const bf16x8* qr, int r32, int hi) {
  p0 = f32x16{}; p1 = f32x16{};
  for (int d0 = 0; d0 < 8; ++d0) { int cb = (d0 * 16 + hi * 8) * 2;
    bf16x8 b0 = *reinterpret_cast<const LAS bf16x8*>(Ks + KSWZ(r32, cb));
    bf16x8 b1 = *reinterpret_cast<const LAS bf16x8*>(Ks + KSWZ(32 + r32, cb));
    p0 = __builtin_amdgcn_mfma_f32_32x32x16_bf16(b0, qr[d0], p0, 0, 0, 0);
    p1 = __builtin_amdgcn_mfma_f32_32x32x16_bf16(b1, qr[d0], p1, 0, 0, 0); }
}
__device__ __forceinline__ int v_st(int k, int c) { const int kk = (k & ~0xC) | ((k & 4) << 1) | ((k & 8) >> 1); return ((kk >> 3) * 4 + (c >> 5)) * 512 + ((kk & 7) * 32 + (c & 31)) * 2; }
__device__ __forceinline__ int v_rd_base(int lane) { return ((lane & 3) << 3) | (((lane >> 2) & 3) << 6) | (((lane >> 4) & 1) << 5) | (((lane >> 5) & 1) << 8); }
constexpr int v_rd_off(int d0, int ks, int half) { return d0 * 512 + ks * 4096 + half * 2048; }
template <int OFF> __device__ __forceinline__ s16x4 tr_read(int vb) {
  s16x4 r; asm volatile("ds_read_b64_tr_b16 %0, %1 offset:%2" : "=&v"(r) : "v"(vb), "i"(OFF) : "memory"); return r;
}
template <int D0> __device__ __forceinline__ void pv_one(f32x16& od, int vb, bf16x8 pa0, bf16x8 pa1, bf16x8 pa2, bf16x8 pa3) {
  const s16x4 l0 = tr_read<v_rd_off(D0, 0, 0)>(vb), h0 = tr_read<v_rd_off(D0, 0, 1)>(vb), l1 = tr_read<v_rd_off(D0, 1, 0)>(vb), h1 = tr_read<v_rd_off(D0, 1, 1)>(vb);
  const s16x4 l2 = tr_read<v_rd_off(D0, 2, 0)>(vb), h2 = tr_read<v_rd_off(D0, 2, 1)>(vb), l3 = tr_read<v_rd_off(D0, 3, 0)>(vb), h3 = tr_read<v_rd_off(D0, 3, 1)>(vb);
  asm volatile("s_waitcnt lgkmcnt(0)" ::: "memory"); SBAR();
#define PK(L, H) (bf16x8){L[0], L[1], L[2], L[3], H[0], H[1], H[2], H[3]}
  od = __builtin_amdgcn_mfma_f32_32x32x16_bf16(pa0, PK(l0, h0), od, 0, 0, 0);
  od = __builtin_amdgcn_mfma_f32_32x32x16_bf16(pa1, PK(l1, h1), od, 0, 0, 0);
  od = __builtin_amdgcn_mfma_f32_32x32x16_bf16(pa2, PK(l2, h2), od, 0, 0, 0);
  od = __builtin_amdgcn_mfma_f32_32x32x16_bf16(pa3, PK(l3, h3), od, 0, 0, 0);
#undef PK
}
__device__ __forceinline__ void pv_d0(f32x16* o, int vb, bf16x8 pa0, bf16x8 pa1, bf16x8 pa2, bf16x8 pa3) {
  pv_one<0>(o[0], vb, pa0, pa1, pa2, pa3); pv_one<1>(o[1], vb, pa0, pa1, pa2, pa3); pv_one<2>(o[2], vb, pa0, pa1, pa2, pa3); pv_one<3>(o[3], vb, pa0, pa1, pa2, pa3);
}

struct MaskNone { static constexpr bool ANY = false; __device__ __forceinline__ void apply(f32x16&, f32x16&, int, int, int, int) const {} };
struct MaskBand {
  static constexpr bool ANY = true; int d0, reach;
  __device__ __forceinline__ void apply(f32x16& p0, f32x16& p1, int tile, int wid, int r32, int hi) const {
    const int base = d0 + tile * 64 - (wid * 32 + r32) + 4 * hi + reach; const unsigned lim = 2u * (unsigned)reach;
#pragma unroll
    for (int r = 0; r < 16; ++r) { const int k = (r & 3) + 8 * (r >> 2);
      if ((unsigned)(base + k) > lim) p0[r] = NEGBIG;
      if ((unsigned)(base + k + 32) > lim) p1[r] = NEGBIG; }
  }
};
struct MaskNA {
  static constexpr bool ANY = true; int qrow0, krow0; const LAS float* tab;
  __device__ __forceinline__ void apply(f32x16& p0, f32x16& p1, int tile, int wid, int r32, int hi) const {
    const int qr = qrow0 + (wid >> 1), kr = krow0 + tile; int rs = qr - 4; rs = rs < 0 ? 0 : (rs > 120 ? 120 : rs);
    if (kr < rs || kr >= rs + 8) {
#pragma unroll
      for (int r = 0; r < 16; ++r) { p0[r] = NEGBIG; p1[r] = NEGBIG; }
    } else {
      const int qc = (wid & 1) * 32 + r32; int cs = qc - 8; cs = cs < 0 ? 0 : (cs > 48 ? 48 : cs);
      const LAS float* trow = tab + (kr - qr + 7) * 128 + 63 - qc + 4 * hi;
      const int cb = 4 * hi - cs;
#pragma unroll
      for (int r = 0; r < 16; ++r) { const int k = (r & 3) + 8 * (r >> 2);
        p0[r] = ((unsigned)(cb + k) < 16u) ? p0[r] + trow[k] : NEGBIG;
        p1[r] = ((unsigned)(cb + k + 32) < 16u) ? p1[r] + trow[k + 32] : NEGBIG; }
    }
  }
};
struct OutGated {
  bf16_t* y; const bf16_t* gate;
  __device__ __forceinline__ void store4(int row, int col, f32x4 v) const {
    const u32x2 g = *(const u32x2*)((const char*)gate + (unsigned)(row * INC + col) * 2u);
    u32x2 w; w.x = cvt_pk_bf16(v.x * bf_lo(g.x), v.y * bf_hi(g.x)); w.y = cvt_pk_bf16(v.z * bf_lo(g.y), v.w * bf_hi(g.y));
    *(u32x2*)((char*)y + (unsigned)(row * DM + col) * 2u) = w; }
  __device__ __forceinline__ void lse(int, float, float) const {}
};
struct OutPartial {
  bf16_t* po; float* plse; int dil;
  __device__ __forceinline__ void store4(int row, int col, f32x4 v) const {
    u32x2 w; w.x = cvt_pk_bf16(v.x, v.y); w.y = cvt_pk_bf16(v.z, v.w);
    *(u32x2*)((char*)po + (unsigned)(row * dil * 512 + col) * 2u) = w; }
  __device__ __forceinline__ void lse(int row, float m, float l) const { plse[(unsigned)(row * dil * 4)] = m * SCALE + __logf(l); }
};
constexpr int TAB_OFF = 67584, STG_OFF = 75776, STG_STRIDE = 68, STG_WAVE = 32 * STG_STRIDE * 4;

template <class Mask, class Out, int SD = 2>
__device__ __forceinline__ void attn_unit(const bf16_t* __restrict__ Qb, const bf16_t* __restrict__ Kh, const bf16_t* __restrict__ Vh, const int ldq, const int ldk,
                                          const int NT, const float m_init, const float l_init, const Mask& mask, const Out& out, LAS char* lds) {
  int tid = threadIdx.x; asm volatile("" : "+v"(tid));
  const int wid = __builtin_amdgcn_readfirstlane(tid >> 6), lane = tid & 63, r32 = lane & 31, hi = lane >> 5;
  LAS char* V_lds = lds; LAS char* K_lds = lds + 2 * SHM_V;
  LAS float* ws = (LAS float*)(lds + 2 * SHM_V + 2 * SHM_K) + wid * 64; LAS float* li_l = ws; LAS float* al_l = ws + 32;
  float m_reg = m_init, l_reg = l_init; f32x16 o[4] = {}; bf16x8 qr[8];
  { const unsigned qoff = (unsigned)((wid * QBLK + r32) * ldq + hi * 8) * 2u;
#pragma unroll
    for (int d0 = 0; d0 < 8; ++d0) qr[d0] = *reinterpret_cast<const bf16x8*>((const char*)Qb + qoff + d0 * 32); }
  const unsigned kvoff = (unsigned)(sr_f(tid) * ldk + (tid & 15) * 8) * 2u; const size_t tileb = (size_t)ldk * 2, half32 = tileb * 32;
  const int sr = tid >> 4, sc = (tid & 15) * 8, vst0 = v_st(sr, sc), vst1 = v_st(32 + sr, sc);
  const int vb0 = (int)(uintptr_t)V_lds + v_rd_base(lane);
  struct { bf16x8 vs0, vs1, ks0, ks1; } sr_[SD];
#define SLOAD(i, k0) do { const char* vp_ = (const char*)Vh + (size_t)(k0) * tileb; const char* kp_ = (const char*)Kh + (size_t)(k0) * tileb; \
    sr_[i].vs0 = *reinterpret_cast<const bf16x8*>(vp_ + kvoff); sr_[i].vs1 = *reinterpret_cast<const bf16x8*>(vp_ + half32 + kvoff); \
    sr_[i].ks0 = *reinterpret_cast<const bf16x8*>(kp_ + kvoff); sr_[i].ks1 = *reinterpret_cast<const bf16x8*>(kp_ + half32 + kvoff); } while (0)
#define SWRITE(b, i) do { *(LAS bf16x8*)(V_lds + (b) * SHM_V + vst0) = sr_[i].vs0;          \
    *(LAS bf16x8*)(V_lds + (b) * SHM_V + vst1) = sr_[i].vs1; int kc = sc * 2;               \
    *(LAS bf16x8*)(K_lds + (b) * SHM_K + KSWZ(sr, kc)) = sr_[i].ks0;                       \
    *(LAS bf16x8*)(K_lds + (b) * SHM_K + KSWZ(32 + sr, kc)) = sr_[i].ks1; } while (0)
#define SWAIT() do { if constexpr (SD == 2) asm volatile("s_waitcnt vmcnt(4)" ::: "memory"); else asm volatile("s_waitcnt vmcnt(0)" ::: "memory"); } while (0)
#define RESC(a) do { if (__any((a) < 1.f)) { if (hi == 0) al_l[r32] = (a); asm volatile("s_waitcnt lgkmcnt(0)" ::: "memory"); \
    for (int d = 0; d < 4; ++d) for (int r = 0; r < 16; ++r) o[d][r] *= al_l[crow(r, hi)]; } } while (0)
  f32x16 pA0, pA1, pB0, pB1; float mnA, mnB, alA, alB; bf16x8 pa0, pa1, pa2, pa3;
  constexpr int SE = 0, SO = SD - 1;
  SLOAD(SE, 0); asm volatile("s_waitcnt vmcnt(0)" ::: "memory"); SWRITE(0, SE); __syncthreads();
  qkt(pA0, pA1, K_lds, qr, r32, hi); mask.apply(pA0, pA1, 0, wid, r32, hi); partialSM(pA0, pA1, m_reg, mnA, alA);
  SLOAD(SO, KVBLK); if constexpr (SD == 2) { if (2 < NT) SLOAD(SE, 2 * KVBLK); }
  SWAIT(); SWRITE(1, SO); __syncthreads();
  for (int j = 1; j + 1 < NT; j += 2) {
    SBAR(); qkt(pB0, pB1, K_lds + SHM_K, qr, r32, hi);
    finishSM(pA0, pA1, alA, l_reg, pa0, pa1, pa2, pa3); SBAR();
    SLOAD(SO, (j + SD) * KVBLK); SBAR();
    pv_d0(o, vb0, pa0, pa1, pa2, pa3); mask.apply(pB0, pB1, j, wid, r32, hi); partialSM(pB0, pB1, m_reg, mnB, alB);
    __syncthreads(); SWAIT(); SWRITE(0, SE);
    RESC(alB); __syncthreads();
    SBAR(); qkt(pA0, pA1, K_lds, qr, r32, hi);
    finishSM(pB0, pB1, alB, l_reg, pa0, pa1, pa2, pa3); SBAR();
    if (SD == 1 || j + 3 < NT) SLOAD(SE, (j + 1 + SD) * KVBLK); SBAR();
    pv_d0(o, vb0 + (int)SHM_V, pa0, pa1, pa2, pa3); mask.apply(pA0, pA1, j + 1, wid, r32, hi); partialSM(pA0, pA1, m_reg, mnA, alA);
    __syncthreads(); SWAIT(); SWRITE(1, SO);
    RESC(alA); __syncthreads();
  }
  SBAR(); qkt(pB0, pB1, K_lds + SHM_K, qr, r32, hi);
  finishSM(pA0, pA1, alA, l_reg, pa0, pa1, pa2, pa3); SBAR();
  pv_d0(o, vb0, pa0, pa1, pa2, pa3); mask.apply(pB0, pB1, NT - 1, wid, r32, hi); partialSM(pB0, pB1, m_reg, mnB, alB);
  __syncthreads(); RESC(alB);
  finishSM(pB0, pB1, alB, l_reg, pa0, pa1, pa2, pa3); SBAR();
  pv_d0(o, vb0 + (int)SHM_V, pa0, pa1, pa2, pa3);
  if (hi == 0) { li_l[r32] = l_reg; out.lse(wid * QBLK + r32, m_reg, l_reg); } asm volatile("s_waitcnt lgkmcnt(0)" ::: "memory");
  float rli[16];
#pragma unroll
  for (int r = 0; r < 16; ++r) rli[r] = __builtin_amdgcn_rcpf(li_l[crow(r, hi)]);
  LAS float* stg = (LAS float*)(lds + STG_OFF + wid * STG_WAVE);
#pragma unroll
  for (int half = 0; half < 2; ++half) {
#pragma unroll
    for (int r = 0; r < 16; ++r) {
      stg[crow(r, hi) * STG_STRIDE + r32] = o[half * 2][r] * rli[r]; stg[crow(r, hi) * STG_STRIDE + 32 + r32] = o[half * 2 + 1][r] * rli[r]; }
    asm volatile("s_waitcnt lgkmcnt(0)" ::: "memory");
#pragma unroll
    for (int i = 0; i < 8; ++i) { const int row = i * 4 + (lane >> 4), c4 = (lane & 15) * 4;
      const f32x4 v = *(const LAS f32x4*)(stg + row * STG_STRIDE + c4);
      out.store4(wid * QBLK + row, half * 64 + c4, v); }
    asm volatile("s_waitcnt lgkmcnt(0)" ::: "memory");
  }
#undef SLOAD
#undef SWRITE
#undef SWAIT
#undef RESC
}
}

#ifndef PH_A
#define PH_A 1
#endif
#ifndef PH_B
#define PH_B 1
#endif
#ifndef PH_C
#define PH_C 1
#endif
#ifndef PH_D
#define PH_D 1
#endif
#ifndef PH_G1
#define PH_G1 1
#endif
#ifndef PH_G2
#define PH_G2 1
#endif
#ifndef PH_G3
#define PH_G3 1
#endif

#ifndef PROBE
#define PROBE 0
#endif
#define REPS(k) ((PROBE == (k)) ? 2 : 1)
#define GSYNC() do { xcd_barrier(xbar); if (PROBE == 1) xcd_barrier(xbar); } while (0)

#define XB_TMO      128
#define XB_XCNT(j)  (256  + 64 * (j))
#define XB_XSUB(j)  (1280 + 64 * (j))
#define XB_XGEN(j)  (2304 + 64 * (j))
#define XB_TOP      3328
#define XB_TOPGEN   3392
#define XCD_BAR_WORDS 3456
#define XB_SPIN_CAP (1u << 18)

__device__ __forceinline__ unsigned xb_ld(unsigned* p)              { return __hip_atomic_load(p, __ATOMIC_RELAXED, __HIP_MEMORY_SCOPE_AGENT); }
__device__ __forceinline__ unsigned xb_add(unsigned* p, unsigned v) { return __hip_atomic_fetch_add(p, v, __ATOMIC_RELAXED, __HIP_MEMORY_SCOPE_AGENT); }
__device__ __forceinline__ unsigned xb_xcc_id() { return (unsigned)__builtin_amdgcn_s_getreg((3 << 11) | 20) & 0xFu; }
#define XB_SPIN(cond, bar) do { unsigned _sp = 0; while (cond) { __builtin_amdgcn_s_sleep(1); \
    if ((++_sp & 255u) == 0u) { if (xb_ld(&(bar)[XB_TMO])) break; if (_sp > XB_SPIN_CAP) { atomicAdd(&(bar)[XB_TMO], 1u); break; } } } } while (0)

struct XcdBarrier {
    unsigned* bar; unsigned x;
    volatile LAS unsigned* st;
};

__device__ __forceinline__ XcdBarrier xcd_barrier_post(unsigned* bar, volatile LAS unsigned* st) {
    XcdBarrier b; b.bar = bar; b.x = xb_xcc_id(); b.st = st;
    if (threadIdx.x == 0) (void)xb_add(&bar[XB_XCNT(b.x)], 1u);
    return b;
}
__device__ __forceinline__ void xcd_barrier_complete(unsigned* bar, unsigned x, unsigned& nloc, unsigned& nx) {
    const unsigned G = gridDim.x * gridDim.y * gridDim.z;
    unsigned sum, cnt, mine, sp = 0u;
    for (;;) {
        sum = 0u; cnt = 0u; mine = 0u;
#pragma unroll
        for (unsigned j = 0; j < 16; ++j) { const unsigned c = xb_ld(&bar[XB_XCNT(j)]); sum += c; cnt += (c > 0u) ? 1u : 0u; mine = (j == x) ? c : mine; }
        if (sum == G) break;
        __builtin_amdgcn_s_sleep(1);
        if ((++sp & 255u) == 0u) { if (xb_ld(&bar[XB_TMO])) break; if (sp > XB_SPIN_CAP) { atomicAdd(&bar[XB_TMO], 1u); break; } }
    }
    nloc = mine > 0u ? mine : 1u; nx = cnt > 0u ? cnt : 1u;
}

__device__ __forceinline__ void xcd_barrier(const XcdBarrier& b) {
    asm volatile("s_waitcnt vmcnt(0)" ::: "memory");
    __syncthreads();
    if (threadIdx.x == 0) {
        unsigned* bar = b.bar;
        __builtin_amdgcn_s_waitcnt(0);
        unsigned nloc = b.st[0], nx = b.st[1];
        if (nloc == 0u) { xcd_barrier_complete(bar, b.x, nloc, nx); b.st[0] = nloc; b.st[1] = nx; }
        const unsigned old = xb_add(&bar[XB_XSUB(b.x)], 1u);
        const unsigned gen = old / nloc;
        if (old + 1u == (gen + 1u) * nloc) {
            __builtin_amdgcn_fence(__ATOMIC_RELEASE, "agent");
            asm volatile("s_waitcnt vmcnt(0)" ::: "memory");
            const unsigned og = xb_add(&bar[XB_TOP], 1u);
            const unsigned tg = og / nx;
            if (og + 1u == (tg + 1u) * nx) xb_add(&bar[XB_TOPGEN], 1u);
            else XB_SPIN(xb_ld(&bar[XB_TOPGEN]) == tg, bar);
            __builtin_amdgcn_fence(__ATOMIC_ACQUIRE, "agent");
            xb_add(&bar[XB_XGEN(b.x)], 1u);
            asm volatile("s_waitcnt vmcnt(0)" ::: "memory");
        } else {
            XB_SPIN(xb_ld(&bar[XB_XGEN(b.x)]) == gen, bar);
            __builtin_amdgcn_fence(__ATOMIC_ACQUIRE, "agent");
            asm volatile("s_waitcnt vmcnt(0)" ::: "memory");
        }
    }
    __syncthreads();
}

struct Params {
  const float *x, *c, *norm_g, *w_ada, *b_ada, *w_in, *a_sink, *c_q_norm, *c_k_norm, *d_rel_bias, *w_gm, *w_branch, *w_out, *final_g;
  float* out; unsigned char* ws;
};
constexpr int LDS_BYTES = 147456, XST_OFF = 146432;

__device__ __forceinline__ float wave_sum(float v) {
#pragma unroll
  for (int o = 1; o < 64; o <<= 1) v += __shfl_xor(v, o);
  return v;
}
template <bool G1PERM>
__device__ __forceinline__ void transpose_item(const float* __restrict__ W, int N, bf16_t* __restrict__ WT, int dpitch, int row_off, int coff, LAS float* scr, int item, int lane) {
  const int nblk = N / 32, kb = item / nblk, nb = item % nblk, k0 = 64 * kb, n0 = 32 * nb;
#pragma unroll 8
  for (int i = 0; i < 32; ++i) { const int kk = 2 * i + (lane >> 5); scr[kk * 33 + (lane & 31)] = W[(size_t)(k0 + kk) * N + n0 + (lane & 31)]; }
  asm volatile("s_waitcnt lgkmcnt(0)" ::: "memory");
  const int c = lane & 7;
#pragma unroll
  for (int j = 0; j < 4; ++j) { const int n = (lane >> 3) + 8 * j; const LAS float* s = scr + (8 * c) * 33 + n;
    u32x4 o; o.x = cvt_pk_bf16(s[0 * 33], s[1 * 33]); o.y = cvt_pk_bf16(s[2 * 33], s[3 * 33]); o.z = cvt_pk_bf16(s[4 * 33], s[5 * 33]); o.w = cvt_pk_bf16(s[6 * 33], s[7 * 33]);
    const int orow = G1PERM ? pg8::g1_row(n0 + n) : (n0 + n);
    *(u32x4*)(WT + (size_t)(row_off + orow) * dpitch + coff + k0 + 8 * c) = o; }
  asm volatile("s_waitcnt lgkmcnt(0)" ::: "memory");
}

__global__ void __launch_bounds__(512) mega_fwd(Params p) {
  extern __shared__ __attribute__((aligned(16))) unsigned char lds_raw[];
  LAS unsigned char* lds = (LAS unsigned char*)lds_raw;
  cg::grid_group grid = cg::this_grid();
  const int G = gridDim.x, cb = blockIdx.x, NGW = G * 8;
  volatile LAS unsigned* xst = (volatile LAS unsigned*)(lds + XST_OFF);
  if (threadIdx.x < 2) xst[threadIdx.x] = 0u;
  __syncthreads();
  const XcdBarrier xbar = xcd_barrier_post((unsigned*)(p.ws + WS_BAR), xst);
#define PHASE_IDS int tid = threadIdx.x; asm volatile("" : "+v"(tid)); const int lane = tid & 63, wave = __builtin_amdgcn_readfirstlane(tid >> 6), gw = cb * 8 + wave; (void)lane; (void)gw;
  unsigned char* ws = p.ws;
  bf16_t* WT1 = (bf16_t*)(ws + WS_WT1); bf16_t* WT2 = (bf16_t*)(ws + WS_WT2); bf16_t* WT3 = (bf16_t*)(ws + WS_WT3);
  bf16_t* HB = (bf16_t*)(ws + WS_H); bf16_t* YB = HB; bf16_t* QKVG = (bf16_t*)(ws + WS_QKVG); bf16_t* MERGED = QKVG; bf16_t* MG = (bf16_t*)(ws + WS_MG);
  bf16_t* PO = (bf16_t*)(ws + WS_PO); float* PLSE = (float*)(ws + WS_PLSE); float* ADA = (float*)(ws + WS_ADA);

  for (int rep = 0; rep < REPS(4); ++rep) {
    PHASE_IDS
    __syncthreads();
    LAS float* sc = (LAS float*)lds; LAS float* red = (LAS float*)(lds + 16384);
    for (int i = tid; i < NB * DM; i += 512) { const float v = p.c[i]; sc[i] = v * sigmoidf_(v); }
    __syncthreads();
    for (int u = cb; u < DEPTH * 96; u += G) {
      const int l = u / 96, jb = u % 96, col = jb * 64 + lane;
      const float* W = p.w_ada + (size_t)l * DM * (3 * DM) + col;
      float a0 = 0.f, a1 = 0.f; const int k0 = wave * 256;
#pragma unroll 8
      for (int k = 0; k < 256; ++k) { const float w = W[(size_t)(k0 + k) * (3 * DM)]; a0 += sc[k0 + k] * w; a1 += sc[DM + k0 + k] * w; }
      red[(wave * 2 + 0) * 64 + lane] = a0; red[(wave * 2 + 1) * 64 + lane] = a1;
      __syncthreads();
      if (tid < 128) { const int b = tid >> 6, cc = tid & 63; float s = 0.f;
#pragma unroll
        for (int w = 0; w < 8; ++w) s += red[(w * 2 + b) * 64 + cc];
        ADA[(size_t)(l * NB + b) * (3 * DM) + jb * 64 + cc] = s + p.b_ada[l * 3 * DM + jb * 64 + cc]; }
      __syncthreads();
    }
    __syncthreads();
    LAS float* scr = (LAS float*)(lds + wave * 16384);
    constexpr int I_IN = 32 * (INC / 32), I_GM = 32 * (GMC / 32), I_BR = 4 * 8 * 64, I_OUT = 32 * 64, I_L = I_IN + I_GM + I_BR + I_OUT;
    for (int it = gw; it < DEPTH * I_L; it += NGW) {
      const int l = it / I_L; int r = it % I_L;
      if (r < I_IN) { transpose_item<true>(p.w_in + (size_t)l * DM * INC, INC, WT1 + (size_t)l * N1 * DM, DM, 0, 0, scr, r, lane); continue; } r -= I_IN;
      if (r < I_GM) { transpose_item<false>(p.w_gm + (size_t)l * DM * GMC, GMC, WT1 + (size_t)l * N1 * DM, DM, INC, 0, scr, r, lane); continue; } r -= I_GM;
      if (r < I_BR) { const int n = r / 512; transpose_item<false>(p.w_branch + (size_t)(l * 4 + n) * 512 * DM, DM, WT2 + (size_t)l * DM * DM, DM, 0, n * 512, scr, r % 512, lane); continue; } r -= I_BR;
      transpose_item<false>(p.w_out + (size_t)l * DM * DM, DM, WT3 + (size_t)l * DM * DM, DM, 0, 0, scr, r, lane);
    }
  }
  grid.sync();

#pragma unroll 1
  for (int l = 0; l < DEPTH; ++l) {
    const float* xin = (l == 0) ? p.x : p.out;
    for (int rep = 0; rep < REPS(4); ++rep) { PHASE_IDS
    for (int row = gw; row < NTOK; row += NGW) {
      const int b = row >> 13;
      const f32x4* xr = (const f32x4*)(xin + (size_t)row * DM) + lane;
      f32x4 v[8]; float ss = 0.f;
#pragma unroll
      for (int j = 0; j < 8; ++j) { v[j] = xr[64 * j]; ss += (v[j].x * v[j].x + v[j].y * v[j].y) + (v[j].z * v[j].z + v[j].w * v[j].w); }
      const float rstd = rsqrtf(wave_sum(ss) * (1.f / DM) + EPS);
      const float* ad = ADA + (size_t)(l * NB + b) * (3 * DM);
      u32x2* o8 = (u32x2*)(HB + (size_t)row * DM) + lane;
#pragma unroll
      for (int j = 0; j < 8; ++j) { const int col = (64 * j + lane) * 4;
        const f32x4 g = *(const f32x4*)(p.norm_g + l * DM + col), sh = *(const f32x4*)(ad + col), scl = *(const f32x4*)(ad + DM + col);
        const f32x4 y = (v[j] * rstd * g) * (scl + 1.0f) + sh;
        u32x2 w; w.x = cvt_pk_bf16(y.x, y.y); w.y = cvt_pk_bf16(y.z, y.w); o8[64 * j] = w; }
    } }
    GSYNC();
#if PH_G1
    for (int rep = 0; rep < REPS(2); ++rep) { pg8::Gemm g{HB, WT1 + (size_t)l * N1 * DM, DM, DM}; pg8::Order S; S.init(NTOK, N1, G, cb, 0);
      pg8::EpiG1 E{QKVG, MG}; pg8::gemm_phase<pg8::EpiG1>(lds, g, S, E); }
#endif
    GSYNC();
    for (int rep = 0; rep < REPS(3); ++rep) { PHASE_IDS
    for (int it0 = gw; it0 < NTOK * 2; it0 += 4 * NGW) {
      const int l16 = lane & 15, sub = lane >> 4;
      int e0; const float* inv;
      if (l16 < 8) { e0 = 4 * l16; inv = INV32 + e0; } else { e0 = 64 + 4 * (l16 - 8); inv = INV32 + (e0 - 64); }
      const f32x4 iv = *(const f32x4*)inv;
      u32x2 ra[4], rb[4]; bf16_t* bp[4]; bool act[4];
#pragma unroll
      for (int k = 0; k < 4; ++k) { const int it = it0 + k * NGW; const int tok = it >> 1, isk = it & 1;
        act[k] = (it < NTOK * 2) && (isk == 0 || sub < 2);
        bp[k] = QKVG + (size_t)(act[k] ? tok : 0) * INC + (isk ? KC : QC) + (act[k] ? sub : 0) * 128 + e0;
        ra[k] = *(const u32x2*)bp[k]; rb[k] = *(const u32x2*)(bp[k] + 32); }
#pragma unroll
      for (int k = 0; k < 4; ++k) { const int it = it0 + k * NGW; const int tok = it >> 1, isk = it & 1, s = tok & (SEQ - 1);
        const float pos = (l16 < 8) ? (float)(s >> 6) : (float)(s & 63);
        float a[4] = {bf_lo(ra[k].x), bf_hi(ra[k].x), bf_lo(ra[k].y), bf_hi(ra[k].y)}, b[4] = {bf_lo(rb[k].x), bf_hi(rb[k].x), bf_lo(rb[k].y), bf_hi(rb[k].y)};
        float ss = (a[0] * a[0] + a[1] * a[1]) + (a[2] * a[2] + a[3] * a[3]) + (b[0] * b[0] + b[1] * b[1]) + (b[2] * b[2] + b[3] * b[3]);
        ss += __shfl_xor(ss, 1); ss += __shfl_xor(ss, 2); ss += __shfl_xor(ss, 4); ss += __shfl_xor(ss, 8);
        const float rstd = rsqrtf(ss * (1.f / 128.f) + EPS); const float* wn = (isk ? p.c_k_norm : p.c_q_norm) + l * 128 + e0;
        const f32x4 wa_ = *(const f32x4*)wn, wb_ = *(const f32x4*)(wn + 32);
        float oa[4], ob[4];
#pragma unroll
        for (int j = 0; j < 4; ++j) { const float av = a[j] * rstd * wa_[j], bv = b[j] * rstd * wb_[j];
          const float ang = pos * iv[j]; double rev = (double)ang * 0.15915494309189535; rev -= __builtin_rint(rev);
          const float fr = (float)rev, sn = __builtin_amdgcn_sinf(fr), cs = __builtin_amdgcn_cosf(fr);
          oa[j] = av * cs - bv * sn; ob[j] = bv * cs + av * sn; }
        u32x2 wa, wb; wa.x = cvt_pk_bf16(oa[0], oa[1]); wa.y = cvt_pk_bf16(oa[2], oa[3]); wb.x = cvt_pk_bf16(ob[0], ob[1]); wb.y = cvt_pk_bf16(ob[2], ob[3]);
        if (act[k]) { *(u32x2*)bp[k] = wa; *(u32x2*)(bp[k] + 32) = wb; } }
    }
    for (int u = cb; u < 1280; u += G) {
#if PH_A
      if (u < 256) {
        const int b = u >> 7, hq = (u >> 5) & 3, qb = u & 31, q0 = qb * 256;
        int lo = q0 - 128; if (lo < 0) lo = 0; int hi = q0 + 384; if (hi > SEQ) hi = SEQ;
        const size_t t0 = (size_t)b * SEQ + q0, k0 = (size_t)b * SEQ + lo;
        att::MaskBand mk{lo - q0, 128}; att::OutGated og{YB + t0 * DM + 0 * 512 + hq * 128, QKVG + t0 * INC + GA + hq * 128};
        att::attn_unit(QKVG + t0 * INC + QA + hq * 128, QKVG + k0 * INC + KA + (hq >> 1) * 128, QKVG + k0 * INC + VA + (hq >> 1) * 128, INC, INC, (hi - lo) >> 6,
                       p.a_sink[l * 4 + hq] * (1.0f / att::SCALE), 1.0f, mk, og, (LAS char*)lds);
      } else
#endif
#if PH_B
      if (u >= 256 && u < 1024) {
        const int v = u - 256, pt = v >> 8, b = (v >> 7) & 1, h = (v >> 5) & 3, blk = v & 31;
        const int dsh = 2 * pt, dil = 1 << dsh, L = SEQ >> dsh, bpr = L >> 8;
        const int r = blk / bpr, lb = blk % bpr, l0 = lb * 256;
        int lo = l0 - 64; if (lo < 0) lo = 0; int hi = l0 + 320; if (hi > L) hi = L;
        if (((hi - lo) >> 6) & 1) { if (lo == 0) hi += 64; else lo -= 64; }
        const size_t t0 = (size_t)b * SEQ + r + (size_t)dil * l0, k0 = (size_t)b * SEQ + r + (size_t)dil * lo;
        att::MaskBand mk{lo - l0, 64}; att::OutPartial op{PO + ((size_t)pt * NTOK + t0) * 512 + h * 128, PLSE + ((size_t)pt * NTOK + t0) * 4 + h, dil};
        att::attn_unit(QKVG + t0 * INC + QB_ + h * 128, QKVG + k0 * INC + KB_ + h * 128, QKVG + k0 * INC + VB_ + h * 128, INC * dil, INC * dil, (hi - lo) >> 6,
                       att::MFLOOR, 0.0f, mk, op, (LAS char*)lds);
      } else
#endif
#if PH_D
      if (u >= 1024) {
        const int v = u - 1024, b = v >> 7, h = (v >> 5) & 3, blk = v & 31, r0 = blk * 4;
        int lo = r0 - 4; lo = lo < 0 ? 0 : (lo > 120 ? 120 : lo); int hi = r0 + 3 - 4; hi = (hi < 0 ? 0 : (hi > 120 ? 120 : hi)) + 8;
        if ((hi - lo) & 1) { if (hi < 128) hi += 1; else lo -= 1; }
        LAS float* tab = (LAS float*)(lds + att::TAB_OFF);
        __syncthreads();
        for (int i = tid; i < 15 * 128; i += 512) { const int dr = i >> 7, dc = (i & 127) - 63;
          tab[i] = (dc >= -15 && dc <= 15) ? p.d_rel_bias[(size_t)(l * 4 + h) * 465 + dr * 31 + dc + 15] * (1.0f / att::SCALE) : 0.f; }
        __syncthreads();
        const size_t t0 = (size_t)b * SEQ + r0 * 64, k0 = (size_t)b * SEQ + lo * 64;
        att::MaskNA mk{r0, lo, tab}; att::OutGated og{YB + t0 * DM + 3 * 512 + h * 128, QKVG + t0 * INC + GD + h * 128};
        att::attn_unit<att::MaskNA, att::OutGated, 1>(QKVG + t0 * INC + QD + h * 128, QKVG + k0 * INC + KD + h * 128, QKVG + k0 * INC + VD + h * 128, INC, INC, hi - lo,
                       att::MFLOOR, 0.0f, mk, og, (LAS char*)lds);
      }
#endif
      {}
    } }
    GSYNC();
    for (int rep = 0; rep < REPS(4); ++rep) { PHASE_IDS
    for (int tok = gw; tok < NTOK; tok += NGW) {
      const int h = lane >> 4, c8 = (lane & 15) * 8;
      const float l0 = PLSE[((size_t)0 * NTOK + tok) * 4 + h], l1 = PLSE[((size_t)1 * NTOK + tok) * 4 + h], l2 = PLSE[((size_t)2 * NTOK + tok) * 4 + h];
      const float mx = fmaxf(l0, fmaxf(l1, l2)); float w0 = __expf(l0 - mx), w1 = __expf(l1 - mx), w2 = __expf(l2 - mx); const float rs = 1.0f / (w0 + w1 + w2); w0 *= rs; w1 *= rs; w2 *= rs;
      const u32x4 o0 = *(const u32x4*)(PO + ((size_t)0 * NTOK + tok) * 512 + h * 128 + c8), o1 = *(const u32x4*)(PO + ((size_t)1 * NTOK + tok) * 512 + h * 128 + c8), o2 = *(const u32x4*)(PO + ((size_t)2 * NTOK + tok) * 512 + h * 128 + c8);
      const u32x4 gg = *(const u32x4*)(QKVG + (size_t)tok * INC + GB_ + h * 128 + c8);
      u32x4 y;
#define CMB(F) cvt_pk_bf16((w0 * bf_lo(o0.F) + w1 * bf_lo(o1.F) + w2 * bf_lo(o2.F)) * bf_lo(gg.F), (w0 * bf_hi(o0.F) + w1 * bf_hi(o1.F) + w2 * bf_hi(o2.F)) * bf_hi(gg.F))
      y.x = CMB(x); y.y = CMB(y); y.z = CMB(z); y.w = CMB(w);
#undef CMB
      *(u32x4*)(YB + (size_t)tok * DM + 1 * 512 + h * 128 + c8) = y;
    } }
#if PH_C
    for (int rep = 0; rep < REPS(3) * REPS(6); ++rep)
    for (int u = cb; u < 256; u += G) {
      const int xcd = u & 7, idx = u >> 3, pair = xcd >> 1, b = pair >> 1, kvh = pair & 1, hq = kvh * 2 + (xcd & 1), q0 = idx * 256;
      const size_t t0 = (size_t)b * SEQ + q0, k0 = (size_t)b * SEQ;
      att::MaskNone mk; att::OutGated og{YB + t0 * DM + 2 * 512 + hq * 128, QKVG + t0 * INC + GC + hq * 128};
      att::attn_unit(QKVG + t0 * INC + QC + hq * 128, QKVG + k0 * INC + KC + kvh * 128, QKVG + k0 * INC + VC + kvh * 128, INC, INC, SEQ / 64,
                     att::MFLOOR, 0.0f, mk, og, (LAS char*)lds);
    }
#endif
    GSYNC();
#if PH_G2
    for (int rep = 0; rep < REPS(5); ++rep) { pg8::Gemm g{YB, WT2 + (size_t)l * DM * DM, DM, 512}; pg8::Order S; S.init(NTOK, DM, G, cb, 2);
      pg8::EpiG2 E{MG, MERGED}; pg8::gemm_phase<pg8::EpiG2>(lds, g, S, E); }
#endif
    GSYNC();
#if PH_G3
    for (int rep = 0; rep < REPS(7); ++rep) { pg8::Gemm g{MERGED, WT3 + (size_t)l * DM * DM, DM, DM}; pg8::Order S; S.init(NTOK, DM, G, cb, 0);
      pg8::EpiG3 E{xin, (PROBE == 7 && rep == 0) ? (float*)MG : p.out, ADA + (size_t)(l * NB) * (3 * DM) + 2 * DM}; pg8::gemm_phase<pg8::EpiG3>(lds, g, S, E); }
#endif
    GSYNC();
  }
  { PHASE_IDS
  for (int row = gw; row < NTOK; row += NGW) {
    f32x4* xr = (f32x4*)(p.out + (size_t)row * DM) + lane;
    f32x4 v[8]; float ss = 0.f;
#pragma unroll
    for (int j = 0; j < 8; ++j) { v[j] = xr[64 * j]; ss += (v[j].x * v[j].x + v[j].y * v[j].y) + (v[j].z * v[j].z + v[j].w * v[j].w); }
    const float rstd = rsqrtf(wave_sum(ss) * (1.f / DM) + EPS);
#pragma unroll
    for (int j = 0; j < 8; ++j) { const f32x4 g = *(const f32x4*)(p.final_g + (64 * j + lane) * 4); xr[64 * j] = v[j] * rstd * g; }
  } }
}

extern "C" void kernel_launch(void* const* d_in, const int* in_sizes, int n_in, void* d_out, int out_size, void* d_ws, size_t ws_size, hipStream_t stream) {
  static int grid_blocks = 0;
  if (grid_blocks == 0) {
    if (n_in != 14 || out_size != NTOK * DM || ws_size < WS_END) { fprintf(stderr, "kernel_launch: unexpected shapes (n_in %d out %d ws %zu need %zu)\n", n_in, out_size, ws_size, (size_t)WS_END); grid_blocks = -1; return; }
    int dev = 0, cus = 0, per_cu = 0;
    hipGetDevice(&dev); hipDeviceGetAttribute(&cus, hipDeviceAttributeMultiprocessorCount, dev);
    if (hipFuncSetAttribute((const void*)mega_fwd, hipFuncAttributeMaxDynamicSharedMemorySize, LDS_BYTES) != hipSuccess) { fprintf(stderr, "kernel_launch: hipFuncSetAttribute failed\n"); grid_blocks = -1; return; }
    hipOccupancyMaxActiveBlocksPerMultiprocessor(&per_cu, (const void*)mega_fwd, 512, LDS_BYTES);
    (void)hipGetLastError();
    if (per_cu < 1) per_cu = 1;
    grid_blocks = cus * 1;
  }
  if (grid_blocks < 0) return;
  if (hipMemsetAsync((char*)d_ws + WS_BAR, 0, 16384, stream) != hipSuccess) { fprintf(stderr, "kernel_launch: memset failed\n"); return; }
  Params p{};
  p.x = (const float*)d_in[0]; p.c = (const float*)d_in[1]; p.norm_g = (const float*)d_in[2]; p.w_ada = (const float*)d_in[3]; p.b_ada = (const float*)d_in[4];
  p.w_in = (const float*)d_in[5]; p.a_sink = (const float*)d_in[6]; p.c_q_norm = (const float*)d_in[7]; p.c_k_norm = (const float*)d_in[8]; p.d_rel_bias = (const float*)d_in[9];
  p.w_gm = (const float*)d_in[10]; p.w_branch = (const float*)d_in[11]; p.w_out = (const float*)d_in[12]; p.final_g = (const float*)d_in[13];
  p.out = (float*)d_out; p.ws = (unsigned char*)d_ws;
  void* args[] = {&p};
  hipError_t e = hipLaunchCooperativeKernel((const void*)mega_fwd, dim3(grid_blocks), dim3(512), args, LDS_BYTES, stream);
  if (e != hipSuccess) fprintf(stderr, "cooperative launch failed: %s (grid %d)\n", hipGetErrorString(e), grid_blocks);
}
```

```cpp
#include <hip/hip_runtime.h>
#include <hip/hip_bf16.h>
#include <hip/hip_cooperative_groups.h>
#include <cstdio>
#include <cstdint>
#include <cmath>
namespace cg = cooperative_groups;

#define LAS __attribute__((address_space(3)))
typedef unsigned short bf16_t;
typedef short bf16x8 __attribute__((ext_vector_type(8)));
typedef short s16x4 __attribute__((ext_vector_type(4)));
typedef float f32x4 __attribute__((ext_vector_type(4)));
typedef float f32x2 __attribute__((ext_vector_type(2)));
typedef float f32x16 __attribute__((ext_vector_type(16)));
typedef unsigned u32x4 __attribute__((ext_vector_type(4)));
typedef unsigned u32x2 __attribute__((ext_vector_type(2)));

__constant__ float INV64[64] = {1.000000000e+00f, 8.659643531e-01f, 7.498942018e-01f, 6.493816376e-01f, 5.623413324e-01f, 4.869675338e-01f, 4.216965139e-01f, 3.651741147e-01f, 3.162277639e-01f, 2.738419771e-01f, 2.371373773e-01f, 2.053525001e-01f, 1.778279394e-01f, 1.539926529e-01f, 1.333521456e-01f, 1.154781953e-01f, 1.000000015e-01f, 8.659642935e-02f, 7.498942316e-02f, 6.493816525e-02f, 5.623413250e-02f, 4.869675264e-02f, 4.216964915e-02f, 3.651741147e-02f, 3.162277490e-02f, 2.738419548e-02f, 2.371373773e-02f, 2.053525113e-02f, 1.778279431e-02f, 1.539926510e-02f, 1.333521400e-02f, 1.154781971e-02f, 9.999999776e-03f, 8.659643121e-03f, 7.498942316e-03f, 6.493816152e-03f, 5.623413250e-03f, 4.869675264e-03f, 4.216964822e-03f, 3.651741194e-03f, 3.162277630e-03f, 2.738419687e-03f, 2.371373819e-03f, 2.053525066e-03f, 1.778279431e-03f, 1.539926510e-03f, 1.333521446e-03f, 1.154782018e-03f, 1.000000047e-03f, 8.659643354e-04f, 7.498941850e-04f, 6.493816036e-04f, 5.623413017e-04f, 4.869675322e-04f, 4.216965172e-04f, 3.651741135e-04f, 3.162277571e-04f, 2.738419571e-04f, 2.371373703e-04f, 2.053525095e-04f, 1.778279402e-04f, 1.539926598e-04f, 1.333521504e-04f, 1.154782003e-04f};
__constant__ float INV32[32] = {1.000000000e+00f, 7.498942018e-01f, 5.623413324e-01f, 4.216965139e-01f, 3.162277639e-01f, 2.371373773e-01f, 1.778279394e-01f, 1.333521456e-01f, 1.000000015e-01f, 7.498942316e-02f, 5.623413250e-02f, 4.216964915e-02f, 3.162277490e-02f, 2.371373773e-02f, 1.778279431e-02f, 1.333521400e-02f, 9.999999776e-03f, 7.498942316e-03f, 5.623413250e-03f, 4.216964822e-03f, 3.162277630e-03f, 2.371373819e-03f, 1.778279431e-03f, 1.333521446e-03f, 1.000000047e-03f, 7.498941850e-04f, 5.623413017e-04f, 4.216965172e-04f, 3.162277571e-04f, 2.371373703e-04f, 1.778279402e-04f, 1.333521504e-04f};

constexpr int DM = 2048, SEQ = 8192, NB = 2, NTOK = NB * SEQ, DEPTH = 4;
constexpr int INC = 7168, GMC = 8192, N1 = INC + GMC;
constexpr float EPS = 1e-6f;
constexpr int QA = 0, KA = 512, VA = 768, GA = 1024, QB_ = 1536, KB_ = 2048, VB_ = 2560, GB_ = 3072, QC = 3584, KC = 4096, VC = 4352, GC = 4608, QD = 5120, KD = 5632, VD = 6144, GD = 6656;

constexpr size_t WS_WT1 = 0;
constexpr size_t WS_WT2 = WS_WT1 + (size_t)DEPTH * N1 * DM * 2;
constexpr size_t WS_WT3 = WS_WT2 + (size_t)DEPTH * DM * DM * 2;
constexpr size_t WS_H = WS_WT3 + (size_t)DEPTH * DM * DM * 2;
constexpr size_t WS_QKVG = WS_H + (size_t)NTOK * DM * 2;
constexpr size_t WS_MG = WS_QKVG + (size_t)NTOK * INC * 2;
constexpr size_t WS_PO = WS_MG + (size_t)NTOK * GMC * 2;
constexpr size_t WS_PLSE = WS_PO + (size_t)3 * NTOK * 512 * 2;
constexpr size_t WS_ADA = WS_PLSE + (size_t)3 * NTOK * 4 * 4;
constexpr size_t WS_BAR = WS_ADA + (size_t)DEPTH * NB * 3 * DM * 4;
constexpr size_t WS_XB = WS_BAR + 16384;
constexpr size_t WS_END = WS_XB + (size_t)NTOK * DM * 2;

typedef __bf16 bf16x2_t __attribute__((ext_vector_type(2)));
__device__ __forceinline__ unsigned cvt_pk_bf16(float lo, float hi) { f32x2 v = {lo, hi}; bf16x2_t b = __builtin_convertvector(v, bf16x2_t); return __builtin_bit_cast(unsigned, b); }
__device__ __forceinline__ float bf_lo(unsigned w) { return __uint_as_float(w << 16); }
__device__ __forceinline__ float bf_hi(unsigned w) { return __uint_as_float(w & 0xffff0000u); }
__device__ __forceinline__ float bf2f(bf16_t v) { return __uint_as_float(((unsigned)v) << 16); }
__device__ __forceinline__ bf16_t f2bf(float f) { return (bf16_t)(cvt_pk_bf16(f, 0.f) & 0xffffu); }
__device__ __forceinline__ float sigmoidf_(float v) { return __builtin_amdgcn_rcpf(1.0f + __expf(-v)); }

namespace pg8 {
constexpr int BM = 256, BK = 64, HALF = 128, HTB = HALF * BK * 2, STAGE_BYTES = 8 * HTB, NXCD = 8, WGM = 8;
__host__ __device__ __forceinline__ int lds_byte(int r, int c) { const int st = (r >> 4) * 2 + (c >> 5), rr = r & 15, cc = c & 31, ob = rr * 64 + cc * 2; return st * 1024 + (ob ^ (((ob >> 9) & 1) << 5)); }
__host__ __device__ __forceinline__ void stage_rc(int b, int& R, int& C) { const int st = b / 1024, sb = b % 1024, swz = sb ^ (((sb >> 9) & 1) << 5); R = (st >> 1) * 16 + swz / 64; C = (st & 1) * 32 + (swz % 64) / 2; }
__host__ __device__ __forceinline__ int perm32(int rho) { const int n = rho >> 4, i = rho & 15; return 8 * (i >> 2) + 4 * n + (i & 3); }

struct Unit { int pm, pn, seg; };
struct Gemm { const bf16_t* A; const bf16_t* Bt; int ld; int kseg; };

struct Order {
    int nM, nN, nwg, G, c, segshift, rev;
    __device__ void init(int M, int N, int G_, int c_, int segshift_, int rev_ = 0) { nM = M / BM; nN = N / BM; nwg = nM * nN; G = G_; c = c_; segshift = segshift_; rev = rev_; }
    __device__ bool next(int i, Unit& u) const {
        const long L = (long)(i >> segshift) * G + c; if (L >= nwg) return false;
        int wgid = (int)L; { const int q = nwg / NXCD, r = nwg % NXCD, xcd = wgid % NXCD, off = wgid / NXCD; wgid = (xcd < r ? xcd * (q + 1) : r * (q + 1) + (xcd - r) * q) + off; }
        const int nig = WGM * nN, gid = wgid / nig, fm = gid * WGM, gsz = (nM - fm) < WGM ? (nM - fm) : WGM;
        u.pm = fm + ((wgid % nig) % gsz); u.pn = (wgid % nig) / gsz; if (rev) u.pn = nN - 1 - u.pn; u.seg = i & ((1 << segshift) - 1); return true;
    }
};


__host__ __device__ __forceinline__ int g1_row(int n) {
    const bool rope = (n < 768) || (n >= 1536 && n < 2560);
    if (!rope) return n;
    const int hb = n & ~127, d = n & 127, dd = d & 63;
    return hb + 8 * (dd >> 2) + (dd & 3) + ((d >> 6) << 2);
}
__host__ __device__ __forceinline__ int gm_row(int c) { const int n = c >> 11, d = c & 2047; return 256 * (d >> 6) + 128 * (n >> 1) + 32 * ((d >> 4) & 3) + 8 * ((d >> 2) & 3) + 4 * (n & 1) + (d & 3); }
struct EpiG1 {
    static constexpr bool PERM = true; static constexpr int PF = 0; static constexpr bool MID = false;
    __device__ __forceinline__ void pf(const Unit&, int, LAS unsigned char*, int, int) const {}
    bf16_t* qkvg; bf16_t* mg;
    __device__ __forceinline__ bool zero_after(const Unit&) const { return true; }
    __device__ __forceinline__ void operator()(f32x4 (&acc)[2][2][4][2], const Unit& u, int wr, int wc, int fr, int fq) const {
        const int row0 = u.pm * BM + wr * 64 + fr; const int pn = u.pn;
        if (pn <= 2 || (pn >= 6 && pn <= 9)) {
            const int g4 = (4 * wc + fq) * 4;
            const f32x4 inv = *(const f32x4*)(INV64 + g4);
#pragma unroll
            for (int ai = 0; ai < 2; ++ai)
#pragma unroll
                for (int m = 0; m < 4; ++m) { const int row = row0 + ai * HALF + m * 16; const float pos = (float)(row & (SEQ - 1));
                    bf16_t* rowp = qkvg + (size_t)row * INC + pn * BM + g4;
                    f32x4 cs, sn;
#pragma unroll
                    for (int e = 0; e < 4; ++e) { const float ang = pos * inv[e]; double rev = (double)ang * 0.15915494309189535; rev -= __builtin_rint(rev);
                        const float fr_ = (float)rev; sn[e] = __builtin_amdgcn_sinf(fr_); cs[e] = __builtin_amdgcn_cosf(fr_); }
#pragma unroll
                    for (int bj = 0; bj < 2; ++bj) { const f32x4 a = acc[ai][bj][m][0], b = acc[ai][bj][m][1];
                        const f32x4 oa = a * cs - b * sn, ob = b * cs + a * sn;
                        u32x2 wa, wb; wa.x = cvt_pk_bf16(oa[0], oa[1]); wa.y = cvt_pk_bf16(oa[2], oa[3]); wb.x = cvt_pk_bf16(ob[0], ob[1]); wb.y = cvt_pk_bf16(ob[2], ob[3]);
                        const auto s0 = __builtin_amdgcn_permlane16_swap(wa.x, wb.x, false, false), s1 = __builtin_amdgcn_permlane16_swap(wa.y, wb.y, false, false);
                        const u32x4 o16 = {s0[0], s1[0], s0[1], s1[1]};
                        *(u32x4*)(rowp + bj * HALF + ((fq & 1) ? 60 : 0)) = o16; } }
            return;
        }
        if (pn >= 28) {
            const int d0 = 64 * (pn - 28) + 16 * wc + 4 * fq;
#pragma unroll
            for (int ai = 0; ai < 2; ++ai)
#pragma unroll
                for (int m = 0; m < 4; ++m) { const int row = row0 + ai * HALF + m * 16;
                    f32x4 ex[4], gg[4];
#pragma unroll
                    for (int n = 0; n < 4; ++n)
#pragma unroll
                        for (int e = 0; e < 4; ++e) { ex[n][e] = __expf(-acc[ai][n >> 1][m][n & 1][e]); gg[n][e] = __builtin_amdgcn_rcpf(1.0f + ex[n][e]); }
                    u32x2 w[4];
#pragma unroll
                    for (int n = 0; n < 4; ++n) { f32x4 r = gg[n]; if (n < 3) r = r * (ex[n + 1] + 1.0f);
                        w[n].x = cvt_pk_bf16(r[0], r[1]); w[n].y = cvt_pk_bf16(r[2], r[3]); }
                    const auto s0 = __builtin_amdgcn_permlane16_swap(w[0].x, w[2].x, false, false), s1 = __builtin_amdgcn_permlane16_swap(w[0].y, w[2].y, false, false);
                    const auto t0 = __builtin_amdgcn_permlane16_swap(w[1].x, w[3].x, false, false), t1 = __builtin_amdgcn_permlane16_swap(w[1].y, w[3].y, false, false);
                    const u32x4 oA = {s0[0], s1[0], s0[1], s1[1]}, oB = {t0[0], t1[0], t0[1], t1[1]};
                    bf16_t* dst = mg + (size_t)((fq & 1) * 2) * NTOK * DM + (size_t)row * DM + (d0 & ~7);
                    *(u32x4*)dst = oA; *(u32x4*)(dst + (size_t)NTOK * DM) = oB; }
            return;
        }
        int mode, ldc, colt; bf16_t* base;
        if (pn < 28) { base = qkvg; ldc = INC; colt = pn * BM; mode = (pn == 4 || pn == 5 || pn == 12 || pn == 13 || pn == 18 || pn == 19 || pn == 26 || pn == 27) ? 1 : 0; }
        else { base = mg + (size_t)((pn - 28) >> 3) * NTOK * DM; ldc = DM; colt = ((pn - 28) & 7) * BM; mode = 2; }
        const int col0 = colt + wc * 32 + 8 * fq;
#pragma unroll
        for (int ai = 0; ai < 2; ++ai)
#pragma unroll
            for (int m = 0; m < 4; ++m) { bf16_t* rowp = base + (size_t)(row0 + ai * HALF + m * 16) * ldc + col0;
#pragma unroll
                for (int bj = 0; bj < 2; ++bj) { f32x4 v0 = acc[ai][bj][m][0], v1 = acc[ai][bj][m][1];
                    if (mode != 0) {
#pragma unroll
                        for (int e = 0; e < 4; ++e) { const float s0 = sigmoidf_(v0[e]), s1 = sigmoidf_(v1[e]); v0[e] = (mode == 1) ? v0[e] * s0 : s0; v1[e] = (mode == 1) ? v1[e] * s1 : s1; }
                    }
                    u32x4 w; w.x = cvt_pk_bf16(v0[0], v0[1]); w.y = cvt_pk_bf16(v0[2], v0[3]); w.z = cvt_pk_bf16(v1[0], v1[1]); w.w = cvt_pk_bf16(v1[2], v1[3]);
                    *(u32x4*)(rowp + bj * HALF) = w; } }
    }
};
struct EpiG2 {
    static constexpr bool PERM = true; static constexpr int PF = 0; static constexpr bool MID = true;
    const bf16_t* mg; bf16_t* out;
    __device__ __forceinline__ void pf(const Unit& u, int step, LAS unsigned char* slot, int wid, int lane) const {
        const int s = step >> 4, row = u.pm * BM + 16 * (step & 15) + 2 * wid + (lane >> 5), g1 = s < 3 ? s + 1 : 3;
        const char* b0 = (const char*)mg + ((size_t)row * GMC + u.pn * BM) * 2 + (lane & 31) * 16;
        __builtin_amdgcn_global_load_lds((const unsigned*)(b0 + (size_t)s * DM * 2), (LAS unsigned*)slot, 16, 0, 0);
        __builtin_amdgcn_global_load_lds((const unsigned*)(b0 + (size_t)g1 * DM * 2), (LAS unsigned*)slot, 16, 0, 0);
    }
    __device__ __forceinline__ bool zero_after(const Unit&) const { return true; }
    template <bool LAST>
    __device__ __forceinline__ void scale(f32x4 (&acc)[2][2][4][2], const Unit& u, int seg, int wr, int wc, int fr, int fq) const {
        const int row0 = u.pm * BM + wr * 64 + fr, col0 = u.pn * BM + wc * 32 + 8 * fq;
        const unsigned goff0 = (unsigned)(seg * (NTOK * DM) + row0 * DM + col0) * 2u;
#pragma unroll
        for (int ai = 0; ai < 2; ++ai)
#pragma unroll
            for (int m = 0; m < 4; ++m) { const int row = row0 + ai * HALF + m * 16; const bf16_t* gp = (const bf16_t*)((const char*)mg + (goff0 + (unsigned)((ai * HALF + m * 16) * DM) * 2u));
#pragma unroll
                for (int bj = 0; bj < 2; ++bj) {
                    const u32x4 ga = *(const u32x4*)(gp + bj * HALF);
                    const float f[8] = {bf_lo(ga.x), bf_hi(ga.x), bf_lo(ga.y), bf_hi(ga.y), bf_lo(ga.z), bf_hi(ga.z), bf_lo(ga.w), bf_hi(ga.w)};
                    f32x4 v0 = acc[ai][bj][m][0], v1 = acc[ai][bj][m][1];
                    v0[0] *= f[0]; v0[1] *= f[1]; v0[2] *= f[2]; v0[3] *= f[3]; v1[0] *= f[4]; v1[1] *= f[5]; v1[2] *= f[6]; v1[3] *= f[7];
                    acc[ai][bj][m][0] = v0; acc[ai][bj][m][1] = v1;
                    if (LAST) { u32x4 w; w.x = cvt_pk_bf16(v0[0], v0[1]); w.y = cvt_pk_bf16(v0[2], v0[3]); w.z = cvt_pk_bf16(v1[0], v1[1]); w.w = cvt_pk_bf16(v1[2], v1[3]);
                        *(u32x4*)(out + (size_t)row * DM + col0 + bj * HALF) = w; } }
                asm volatile("" ::: "memory"); }
    }
    __device__ __forceinline__ void mid(f32x4 (&acc)[2][2][4][2], const Unit& u, int seg, int wr, int wc, int fr, int fq) const { scale<false>(acc, u, seg, wr, wc, fr, fq); }
    __device__ __forceinline__ void operator()(f32x4 (&acc)[2][2][4][2], const Unit& u, int wr, int wc, int fr, int fq) const { scale<true>(acc, u, 3, wr, wc, fr, fq); }
};
struct EpiG3 {
    static constexpr bool PERM = true; static constexpr int PF = 0; static constexpr bool MID = false;
    __device__ __forceinline__ void pf(const Unit& u, int step, LAS unsigned char* slot, int wid, int lane) const {
        const char* a;
        if (xin32) { const int ss = step >= 32 ? step - 32 : 0; a = (const char*)xin32 + ((size_t)(u.pm * BM + 8 * ss + wid) * DM + u.pn * BM) * 4 + lane * 16; }
        else { const int ss = step >= 48 ? step - 48 : 0; a = (const char*)xb + ((size_t)(u.pm * BM + 16 * ss + 2 * wid + (lane >> 5)) * DM + u.pn * BM) * 2 + (lane & 31) * 16; }
        __builtin_amdgcn_global_load_lds((const unsigned*)a, (LAS unsigned*)slot, 16, 0, 0);
    }
    const float* xin32; bf16_t* xb; const float* gate;
    __device__ __forceinline__ bool zero_after(const Unit&) const { return true; }
    __device__ __forceinline__ void operator()(f32x4 (&acc)[2][2][4][2], const Unit& u, int wr, int wc, int fr, int fq) const {
        const int col0 = u.pn * BM + wc * 32 + 8 * fq;
        const float* gp = gate + (size_t)((u.pm * BM) >> 13) * (3 * DM) + col0;
        f32x4 gv[2][2];
#pragma unroll
        for (int bj = 0; bj < 2; ++bj)
#pragma unroll
            for (int n = 0; n < 2; ++n) gv[bj][n] = *(const f32x4*)(gp + bj * HALF + n * 4);
#pragma unroll
        for (int ai = 0; ai < 2; ++ai)
#pragma unroll
            for (int m = 0; m < 4; ++m) { const size_t off = (size_t)(u.pm * BM + ai * HALF + wr * 64 + m * 16 + fr) * DM + col0;
#pragma unroll
                for (int bj = 0; bj < 2; ++bj) { f32x4 x0, x1;
                    if (xin32) { x0 = *(const f32x4*)(xin32 + off + bj * HALF); x1 = *(const f32x4*)(xin32 + off + bj * HALF + 4); }
                    else { const u32x4 r = *(const u32x4*)(xb + off + bj * HALF); x0 = (f32x4){bf_lo(r.x), bf_hi(r.x), bf_lo(r.y), bf_hi(r.y)}; x1 = (f32x4){bf_lo(r.z), bf_hi(r.z), bf_lo(r.w), bf_hi(r.w)}; }
                    const f32x4 y0 = x0 + gv[bj][0] * acc[ai][bj][m][0], y1 = x1 + gv[bj][1] * acc[ai][bj][m][1];
                    u32x4 w; w.x = cvt_pk_bf16(y0[0], y0[1]); w.y = cvt_pk_bf16(y0[2], y0[3]); w.z = cvt_pk_bf16(y1[0], y1[1]); w.w = cvt_pk_bf16(y1[2], y1[3]);
                    *(u32x4*)(xb + off + bj * HALF) = w; }
                if (m & 1) asm volatile("" ::: "memory"); }
    }
};

template <class Epi, bool ALIGN = true>
__device__ __forceinline__ void gemm_phase(LAS unsigned char* lds, const Gemm g, const Order& S, const Epi& E) {
    int tid = threadIdx.x; asm volatile("" : "+v"(tid));
    const int wid = __builtin_amdgcn_readfirstlane(tid >> 6), lane = tid & 63, wr = wid >> 2, wc = wid & 3, fr = lane & 15, fq = lane >> 4;
    const int K = g.ld, nt = g.kseg / BK;
    unsigned voffA[2], voffB[2];
#pragma unroll
    for (int i = 0; i < 2; ++i) { int R, C; stage_rc(tid * 16 + i * 8192, R, C); const int Rb = Epi::PERM ? ((R & ~31) + perm32(R & 31)) : R;
        voffA[i] = (unsigned)(R * K + C) * 2u; voffB[i] = (unsigned)(Rb * K + C) * 2u; }
    const size_t kstep = (size_t)(BK * 2);
    const size_t hstep = (size_t)HALF * K * 2;
    const size_t tstep = 2 * hstep;
    const size_t sstep = (size_t)g.kseg * 2;
    const unsigned ldsw = (unsigned)wid * 1024u;
    const int aoff = lds_byte(wr * 64 + fr, fq * 8), boff = lds_byte(wc * 32 + fr, fq * 8);
    LAS unsigned char* pfslot = lds + STAGE_BYTES + ldsw;
#define PG8_SA(b, h) (((b) * 2 + (h)) * HTB)
#define PG8_SB(b, h) ((4 + (b) * 2 + (h)) * HTB)
#define PG8_STAGE(bufoff, gbase, voff) do { _Pragma("unroll") for (int _i = 0; _i < 2; ++_i) \
        __builtin_amdgcn_global_load_lds((const unsigned*)((const char*)(gbase) + (voff)[_i]), (LAS unsigned*)(lds + (bufoff) + ldsw + _i * 8192), 16, 0, 0); } while (0)
#define PG8_LDA(dst, b, h) do { _Pragma("unroll") for (int m = 0; m < 4; ++m) _Pragma("unroll") for (int k = 0; k < 2; ++k) dst[m][k] = *(const LAS bf16x8*)(lds + PG8_SA(b, h) + aoff + m * 2048 + k * 1024); } while (0)
#define PG8_LDB(dst, b, h) do { _Pragma("unroll") for (int n = 0; n < 2; ++n) _Pragma("unroll") for (int k = 0; k < 2; ++k) dst[n][k] = *(const LAS bf16x8*)(lds + PG8_SB(b, h) + boff + n * 2048 + k * 1024); } while (0)
#define PG8_MMA(ai, bj, At, Bt) do { __builtin_amdgcn_s_setprio(1); _Pragma("unroll") for (int m = 0; m < 4; ++m) _Pragma("unroll") for (int n = 0; n < 2; ++n) _Pragma("unroll") for (int k = 0; k < 2; ++k) \
        acc[ai][bj][m][n] = __builtin_amdgcn_mfma_f32_16x16x32_bf16(Bt[n][k], At[m][k], acc[ai][bj][m][n], 0, 0, 0); __builtin_amdgcn_s_setprio(0); } while (0)
#define PG8_WAIT_V(n) asm volatile("s_waitcnt vmcnt(" #n ")" ::: "memory")
#define PG8_WAIT_VL() asm volatile("s_waitcnt vmcnt(%0)" :: "n"(8 + 3 * Epi::PF) : "memory")
#define PG8_PF(j) do { if constexpr (Epi::PF > 0) E.pf(cur, 2 * t + (j), pfslot, wid, lane); } while (0)
#define PG8_WAIT_L(n) asm volatile("s_waitcnt lgkmcnt(" #n ")" ::: "memory")
#define PG8_BAR __builtin_amdgcn_s_barrier()
#define PG8_SCHED __builtin_amdgcn_sched_barrier(0)
#define PG8_UA(u) ((const char*)g.A + (size_t)(u).pm * tstep + (size_t)(u).seg * sstep)
#define PG8_UB(u) ((const char*)g.Bt + (size_t)(u).pn * tstep + (size_t)(u).seg * sstep)
    Unit cur, nxt; int ui = 0;
    if (!S.next(0, cur)) return;
    f32x4 acc[2][2][4][2];
#pragma unroll
    for (int a = 0; a < 2; ++a)
#pragma unroll
        for (int b = 0; b < 2; ++b)
#pragma unroll
            for (int m = 0; m < 4; ++m)
#pragma unroll
                for (int n = 0; n < 2; ++n) acc[a][b][m][n] = (f32x4){0.f, 0.f, 0.f, 0.f};
    bf16x8 At[4][2], B0[2][2], B1[2][2];
    const char* cA = PG8_UA(cur); const char* cB = PG8_UB(cur);
    PG8_STAGE(PG8_SB(0, 0), cB, voffB); PG8_STAGE(PG8_SB(0, 1), cB + hstep, voffB); PG8_STAGE(PG8_SA(0, 0), cA, voffA); PG8_STAGE(PG8_SA(0, 1), cA + hstep, voffA);
    if (wr == 1) PG8_BAR;
    PG8_WAIT_V(2); PG8_BAR;
    PG8_STAGE(PG8_SB(1, 0), cB + kstep, voffB); PG8_STAGE(PG8_SA(1, 0), cA + kstep, voffA); PG8_STAGE(PG8_SB(1, 1), cB + hstep + kstep, voffB);
    PG8_WAIT_V(6); PG8_BAR;
    for (;;) {
        const bool has_next = S.next(ui + 1, nxt);
        const char* nA = has_next ? PG8_UA(nxt) : cA; const char* nB = has_next ? PG8_UB(nxt) : cB;
        for (int t = 0; t < nt; t += 2) {
            const bool last = (t == nt - 2);
            const char* a1 = cA + (size_t)(t + 1) * kstep;
            const char* a2 = last ? nA : cA + (size_t)(t + 2) * kstep; const char* b2 = last ? nB : cB + (size_t)(t + 2) * kstep;
            const char* a3 = a2 + kstep; const char* b3 = b2 + kstep;
            PG8_LDB(B0, 0, 0); PG8_LDB(B1, 0, 1); PG8_SCHED; PG8_LDA(At, 0, 0); PG8_STAGE(PG8_SA(1, 1), a1 + hstep, voffA); PG8_PF(0);
            PG8_WAIT_VL(); PG8_WAIT_L(0); PG8_BAR; PG8_MMA(0, 0, At, B0); PG8_MMA(0, 1, At, B1); PG8_BAR; PG8_SCHED;
            PG8_LDA(At, 0, 1); PG8_STAGE(PG8_SB(0, 0), b2, voffB); PG8_STAGE(PG8_SB(0, 1), b2 + hstep, voffB); PG8_STAGE(PG8_SA(0, 0), a2, voffA); PG8_PF(1);
            PG8_WAIT_VL(); PG8_WAIT_L(0); PG8_BAR; PG8_MMA(1, 0, At, B0); PG8_MMA(1, 1, At, B1); PG8_BAR; PG8_SCHED;
            PG8_LDB(B0, 1, 0); PG8_LDB(B1, 1, 1); PG8_SCHED; PG8_LDA(At, 1, 0); PG8_STAGE(PG8_SA(0, 1), a2 + hstep, voffA); PG8_PF(2);
            PG8_WAIT_VL(); PG8_WAIT_L(0); PG8_BAR; PG8_MMA(0, 0, At, B0); PG8_MMA(0, 1, At, B1); PG8_BAR; PG8_SCHED;
            PG8_LDA(At, 1, 1); PG8_STAGE(PG8_SB(1, 0), b3, voffB); PG8_STAGE(PG8_SB(1, 1), b3 + hstep, voffB); PG8_STAGE(PG8_SA(1, 0), a3, voffA); PG8_PF(3);
            PG8_WAIT_VL(); PG8_WAIT_L(0); PG8_BAR; PG8_MMA(1, 0, At, B0); PG8_MMA(1, 1, At, B1); PG8_BAR; PG8_SCHED;
            if constexpr (Epi::MID) { if (((t + 2) & 7) == 0 && !last) { E.mid(acc, cur, ((t + 2) >> 3) - 1, wr, wc, fr, fq); PG8_SCHED; } }
        }
        if constexpr (ALIGN) { if (wr == 0) PG8_BAR; }
        E(acc, cur, wr, wc, fr, fq);
        if (!has_next) break;
        if (E.zero_after(cur)) {
#pragma unroll
            for (int a = 0; a < 2; ++a)
#pragma unroll
                for (int b = 0; b < 2; ++b)
#pragma unroll
                    for (int m = 0; m < 4; ++m)
#pragma unroll
                        for (int n = 0; n < 2; ++n) acc[a][b][m][n] = (f32x4){0.f, 0.f, 0.f, 0.f};
        }
        cur = nxt; cA = nA; cB = nB; ++ui;
        if constexpr (ALIGN) { if (wr == 1) PG8_BAR; }
    }
    PG8_WAIT_V(0);
    if constexpr (!ALIGN) { if (wr == 0) PG8_BAR; }
    PG8_BAR;
#undef PG8_SA
#undef PG8_SB
#undef PG8_STAGE
#undef PG8_LDA
#undef PG8_LDB
#undef PG8_MMA
#undef PG8_WAIT_V
#undef PG8_WAIT_VL
#undef PG8_PF
#undef PG8_WAIT_L
#undef PG8_BAR
#undef PG8_SCHED
#undef PG8_UA
#undef PG8_UB
}
}

namespace att {
constexpr int D = 128, NW = 8, QBLK = 32, KVBLK = 64;
constexpr float SCALE = 0.088388347648318440f;
constexpr float THR = 8.f;
constexpr int SDEPTH = 2;
constexpr size_t SHM_V = KVBLK * D * 2, SHM_K = KVBLK * D * 2, SHM_ATTN = 2 * SHM_V + 2 * SHM_K + NW * 64 * 4;
constexpr float NEGBIG = -1e30f, MFLOOR = -30000.f;
#define KSWZ(row, colB) ((row) * 256 + ((colB) ^ (((row) & 7) << 4)))
#define SBAR() __builtin_amdgcn_sched_barrier(0)
__device__ __forceinline__ int sr_f(int tid) { return tid >> 4; }
__device__ __forceinline__ int crow(int r, int hi) { return (r & 3) + 8 * (r >> 2) + 4 * hi; }
__device__ __forceinline__ unsigned cvtpk(float lo, float hi) { return cvt_pk_bf16(lo, hi); }

__device__ __forceinline__ void partialSM(f32x16& p0, f32x16& p1, float& m_reg, float& mn, float& alpha) {
  constexpr float C = SCALE * 1.4426950408889634f;
  float pmax = p0[0]; for (int r = 1; r < 16; ++r) pmax = fmaxf(pmax, p0[r]); for (int r = 0; r < 16; ++r) pmax = fmaxf(pmax, p1[r]);
  { auto rr = __builtin_amdgcn_permlane32_swap(__float_as_uint(pmax), __float_as_uint(pmax), false, false);
    pmax = fmaxf(__uint_as_float(rr[0]), __uint_as_float(rr[1])); }
  if (__builtin_expect(__all(pmax - m_reg <= THR / SCALE), 1)) { mn = m_reg; alpha = 1.f; }
  else { mn = fmaxf(m_reg, pmax); alpha = __builtin_amdgcn_exp2f((m_reg - mn) * C); m_reg = mn; }
  float mnC = -mn * C;
  for (int r = 0; r < 16; ++r) p0[r] = fmaf(p0[r], C, mnC); for (int r = 0; r < 16; ++r) p1[r] = fmaf(p1[r], C, mnC);
  for (int r = 0; r < 16; ++r) p0[r] = __builtin_amdgcn_exp2f(p0[r]);
}
__device__ __forceinline__ void finishSM(f32x16& p0, f32x16& p1, float alpha, float& l_reg, bf16x8& pa0, bf16x8& pa1, bf16x8& pa2, bf16x8& pa3) {
  for (int r = 0; r < 16; ++r) p1[r] = __builtin_amdgcn_exp2f(p1[r]);
  float ps = 0; for (int r = 0; r < 16; ++r) ps += p0[r]; for (int r = 0; r < 16; ++r) ps += p1[r];
  { auto rr = __builtin_amdgcn_permlane32_swap(__float_as_uint(ps), __float_as_uint(ps), false, false);
    ps = __uint_as_float(rr[0]) + __uint_as_float(rr[1]); }
  l_reg = l_reg * alpha + ps;
#define PK4(P, BASE, OUT) do { unsigned a0 = cvtpk(P[BASE + 0], P[BASE + 1]), a1 = cvtpk(P[BASE + 2], P[BASE + 3]);   \
    unsigned b0 = cvtpk(P[BASE + 4], P[BASE + 5]), b1 = cvtpk(P[BASE + 6], P[BASE + 7]);                              \
    auto r0 = __builtin_amdgcn_permlane32_swap(a0, b0, false, false); auto r1 = __builtin_amdgcn_permlane32_swap(a1, b1, false, false); \
    u32x4 w = {r0[0], r1[0], r0[1], r1[1]}; OUT = *reinterpret_cast<bf16x8*>(&w); } while (0)
  PK4(p0, 0, pa0); PK4(p0, 8, pa1); PK4(p1, 0, pa2); PK4(p1, 8, pa3);
#undef PK4
}
__device__ __forceinline__ void qkt(f32x16& p0, f32x16& p1, const LAS char* Ks, const bf16x8* qr, int r32, int hi) {
  p0 = f32x16{}; p1 = f32x16{};
  for (int d0 = 0; d0 < 8; ++d0) { int cb = (d0 * 16 + hi * 8) * 2;
    bf16x8 b0 = *reinterpret_cast<const LAS bf16x8*>(Ks + KSWZ(r32, cb));
    bf16x8 b1 = *reinterpret_cast<const LAS bf16x8*>(Ks + KSWZ(32 + r32, cb));
    p0 = __builtin_amdgcn_mfma_f32_32x32x16_bf16(b0, qr[d0], p0, 0, 0, 0);
    p1 = __builtin_amdgcn_mfma_f32_32x32x16_bf16(b1, qr[d0], p1, 0, 0, 0); }
}
__device__ __forceinline__ int v_st(int k, int c) { const int kk = (k & ~0xC) | ((k & 4) << 1) | ((k & 8) >> 1); return ((kk >> 3) * 4 + (c >> 5)) * 512 + ((kk & 7) * 32 + (c & 31)) * 2; }
__device__ __forceinline__ int v_rd_base(int lane) { return ((lane & 3) << 3) | (((lane >> 2) & 3) << 6) | (((lane >> 4) & 1) << 5) | (((lane >> 5) & 1) << 8); }
constexpr int v_rd_off(int d0, int ks, int half) { return d0 * 512 + ks * 4096 + half * 2048; }
template <int OFF> __device__ __forceinline__ s16x4 tr_read(int vb) {
  s16x4 r; asm volatile("ds_read_b64_tr_b16 %0, %1 offset:%2" : "=&v"(r) : "v"(vb), "i"(OFF) : "memory"); return r;
}
template <int D0> __device__ __forceinline__ void pv_one(f32x16& od, int vb, bf16x8 pa0, bf16x8 pa1, bf16x8 pa2, bf16x8 pa3) {
  const s16x4 l0 = tr_read<v_rd_off(D0, 0, 0)>(vb), h0 = tr_read<v_rd_off(D0, 0, 1)>(vb), l1 = tr_read<v_rd_off(D0, 1, 0)>(vb), h1 = tr_read<v_rd_off(D0, 1, 1)>(vb);
  const s16x4 l2 = tr_read<v_rd_off(D0, 2, 0)>(vb), h2 = tr_read<v_rd_off(D0, 2, 1)>(vb), l3 = tr_read<v_rd_off(D0, 3, 0)>(vb), h3 = tr_read<v_rd_off(D0, 3, 1)>(vb);
  asm volatile("s_waitcnt lgkmcnt(0)" ::: "memory"); SBAR();
#define PK(L, H) (bf16x8){L[0], L[1], L[2], L[3], H[0], H[1], H[2], H[3]}
  od = __builtin_amdgcn_mfma_f32_32x32x16_bf16(pa0, PK(l0, h0), od, 0, 0, 0);
  od = __builtin_amdgcn_mfma_f32_32x32x16_bf16(pa1, PK(l1, h1), od, 0, 0, 0);
  od = __builtin_amdgcn_mfma_f32_32x32x16_bf16(pa2, PK(l2, h2), od, 0, 0, 0);
  od = __builtin_amdgcn_mfma_f32_32x32x16_bf16(pa3, PK(l3, h3), od, 0, 0, 0);
#undef PK
}
__device__ __forceinline__ void pv_d0(f32x16* o, int vb, bf16x8 pa0, bf16x8 pa1, bf16x8 pa2, bf16x8 pa3) {
  pv_one<0>(o[0], vb, pa0, pa1, pa2, pa3); pv_one<1>(o[1], vb, pa0, pa1, pa2, pa3); pv_one<2>(o[2], vb, pa0, pa1, pa2, pa3); pv_one<3>(o[3], vb, pa0, pa1, pa2, pa3);
}

struct MaskNone { static constexpr bool ANY = false; __device__ __forceinline__ void apply(f32x16&, f32x16&, int, int, int, int) const {} };
struct MaskBand {
  static constexpr bool ANY = true; int d0, reach;
  __device__ __forceinline__ void apply(f32x16& p0, f32x16& p1, int tile, int wid, int r32, int hi) const {
    const int base = d0 + tile * 64 - (wid * 32 + r32) + 4 * hi + reach; const unsigned lim = 2u * (unsigned)reach;
#pragma unroll
    for (int r = 0; r < 16; ++r) { const int k = (r & 3) + 8 * (r >> 2);
      if ((unsigned)(base + k) > lim) p0[r] = NEGBIG;
      if ((unsigned)(base + k + 32) > lim) p1[r] = NEGBIG; }
  }
};
struct MaskBand2 {
  static constexpr bool ANY = true; int d0;
  __device__ __forceinline__ void apply(f32x16& p0, f32x16& p1, int tile, int wid, int r32, int hi) const {
    constexpr float LN2R = 0.6931471805599453f / SCALE;
    const int base = d0 + tile * 64 - (wid * 32 + r32) + 4 * hi; const int al = (-base) & 3;
#pragma unroll
    for (int r = 0; r < 16; ++r) { const int k = (r & 3) + 8 * (r >> 2); const bool aligned = ((r & 3) == al);
      { const int d = base + k; const bool v1 = (unsigned)(d + 64) <= 128u, v2 = aligned && ((unsigned)(d + 256) <= 512u);
        p0[r] = v1 ? (v2 ? p0[r] + LN2R : p0[r]) : (v2 ? p0[r] : NEGBIG); }
      { const int d = base + k + 32; const bool v1 = (unsigned)(d + 64) <= 128u, v2 = aligned && ((unsigned)(d + 256) <= 512u);
        p1[r] = v1 ? (v2 ? p1[r] + LN2R : p1[r]) : (v2 ? p1[r] : NEGBIG); } }
  }
};
struct MaskNA {
  static constexpr bool ANY = true; int qrow0, krow0; const LAS float* tab;
  __device__ __forceinline__ void apply(f32x16& p0, f32x16& p1, int tile, int wid, int r32, int hi) const {
    const int qr = qrow0 + (wid >> 1), kr = krow0 + tile; int rs = qr - 4; rs = rs < 0 ? 0 : (rs > 120 ? 120 : rs);
    if (kr < rs || kr >= rs + 8) {
#pragma unroll
      for (int r = 0; r < 16; ++r) { p0[r] = NEGBIG; p1[r] = NEGBIG; }
    } else {
      const int qc = (wid & 1) * 32 + r32; int cs = qc - 8; cs = cs < 0 ? 0 : (cs > 48 ? 48 : cs);
      const LAS float* trow = tab + (kr - qr + 7) * 128 + 63 - qc + 4 * hi;
      const int cb = 4 * hi - cs;
#pragma unroll
      for (int r = 0; r < 16; ++r) { const int k = (r & 3) + 8 * (r >> 2);
        p0[r] = ((unsigned)(cb + k) < 16u) ? p0[r] + trow[k] : NEGBIG;
        p1[r] = ((unsigned)(cb + k + 32) < 16u) ? p1[r] + trow[k + 32] : NEGBIG;
        if ((r & 7) == 7) asm volatile("" ::: "memory"); }
    }
  }
};
struct OutGated {
  bf16_t* y; const bf16_t* gate;
  __device__ __forceinline__ void store8(int row, int col, f32x4 v0, f32x4 v1) const {
    const u32x4 g = *(const u32x4*)((const char*)gate + (unsigned)(row * INC + col) * 2u);
    u32x4 w; w.x = cvt_pk_bf16(v0.x * bf_lo(g.x), v0.y * bf_hi(g.x)); w.y = cvt_pk_bf16(v0.z * bf_lo(g.y), v0.w * bf_hi(g.y));
    w.z = cvt_pk_bf16(v1.x * bf_lo(g.z), v1.y * bf_hi(g.z)); w.w = cvt_pk_bf16(v1.z * bf_lo(g.w), v1.w * bf_hi(g.w));
    *(u32x4*)((char*)y + (unsigned)(row * DM + col) * 2u) = w; }
  __device__ __forceinline__ void lse(int, float, float) const {}
};
struct OutPartial {
  bf16_t* po; float* plse; int dil;
  __device__ __forceinline__ void store8(int row, int col, f32x4 v0, f32x4 v1) const {
    u32x4 w; w.x = cvt_pk_bf16(v0.x, v0.y); w.y = cvt_pk_bf16(v0.z, v0.w); w.z = cvt_pk_bf16(v1.x, v1.y); w.w = cvt_pk_bf16(v1.z, v1.w);
    *(u32x4*)((char*)po + (unsigned)(row * dil * 512 + col) * 2u) = w; }
  __device__ __forceinline__ void lse(int row, float m, float l) const { plse[(unsigned)(row * dil * 4)] = m * SCALE + __logf(l); }
};
constexpr int TAB_OFF = 67584, STG_OFF = 75776, STG_STRIDE = 68, STG_WAVE = 32 * STG_STRIDE * 4;

template <class Mask, class Out, int SD = 2, bool PACK2 = false, bool ODD = false>
__device__ __forceinline__ void attn_unit(const bf16_t* __restrict__ Qb, const bf16_t* __restrict__ Kh, const bf16_t* __restrict__ Vh, const int ldq, const int ldk,
                                          const int NT, const float m_init, const float l_init, const Mask& mask, const Out& out, LAS char* lds, const float m_init1 = 0.f) {
  int tid = threadIdx.x; asm volatile("" : "+v"(tid));
  const int wid = __builtin_amdgcn_readfirstlane(tid >> 6), lane = tid & 63, r32 = lane & 31, hi = lane >> 5;
  const int wq = PACK2 ? (wid & 3) : wid, hsel = PACK2 ? (wid >> 2) : 0;
  LAS char* V_lds = lds; LAS char* K_lds = lds + 2 * SHM_V;
  LAS float* ws = (LAS float*)(lds + 2 * SHM_V + 2 * SHM_K) + wid * 64; LAS float* li_l = ws; LAS float* al_l = ws + 32;
  float m_reg = (PACK2 && hsel) ? m_init1 : m_init, l_reg = l_init; f32x16 o[4] = {}; bf16x8 qr[8];
  { const unsigned qoff = (unsigned)((wq * QBLK + r32) * ldq + hi * 8) * 2u + (unsigned)hsel * 256u;
#pragma unroll
    for (int d0 = 0; d0 < 8; ++d0) qr[d0] = *reinterpret_cast<const bf16x8*>((const char*)Qb + qoff + d0 * 32); }
  const unsigned kvoff = (unsigned)(sr_f(tid) * ldk + (tid & 15) * 8) * 2u; const size_t tileb = (size_t)ldk * 2, half32 = tileb * 32;
  const int sr = tid >> 4, sc = (tid & 15) * 8, vst0 = v_st(sr, sc), vst1 = v_st(32 + sr, sc);
  const int vb0 = (int)(uintptr_t)V_lds + v_rd_base(lane);
  struct { bf16x8 vs0, vs1, ks0, ks1; } sr_[SD];
#define SLOAD(i, k0) do { const char* vp_ = (const char*)Vh + (size_t)(k0) * tileb; const char* kp_ = (const char*)Kh + (size_t)(k0) * tileb; \
    sr_[i].vs0 = *reinterpret_cast<const bf16x8*>(vp_ + kvoff); sr_[i].vs1 = *reinterpret_cast<const bf16x8*>(vp_ + half32 + kvoff); \
    sr_[i].ks0 = *reinterpret_cast<const bf16x8*>(kp_ + kvoff); sr_[i].ks1 = *reinterpret_cast<const bf16x8*>(kp_ + half32 + kvoff); } while (0)
#define SWRITE(b, i) do { *(LAS bf16x8*)(V_lds + (b) * SHM_V + vst0) = sr_[i].vs0;          \
    *(LAS bf16x8*)(V_lds + (b) * SHM_V + vst1) = sr_[i].vs1; int kc = sc * 2;               \
    *(LAS bf16x8*)(K_lds + (b) * SHM_K + KSWZ(sr, kc)) = sr_[i].ks0;                       \
    *(LAS bf16x8*)(K_lds + (b) * SHM_K + KSWZ(32 + sr, kc)) = sr_[i].ks1; } while (0)
#define SWAIT() do { if constexpr (SD == 2) asm volatile("s_waitcnt vmcnt(4)" ::: "memory"); else asm volatile("s_waitcnt vmcnt(0)" ::: "memory"); } while (0)
#define RESC(a) do { if (__any((a) < 1.f)) { if (hi == 0) al_l[r32] = (a); asm volatile("s_waitcnt lgkmcnt(0)" ::: "memory"); \
    for (int d = 0; d < 4; ++d) for (int r = 0; r < 16; ++r) o[d][r] *= al_l[crow(r, hi)]; } } while (0)
  f32x16 pA0, pA1, pB0, pB1; float mnA, mnB, alA, alB; bf16x8 pa0, pa1, pa2, pa3;
  constexpr int SE = 0, SO = SD - 1;
  SLOAD(SE, 0); asm volatile("s_waitcnt vmcnt(0)" ::: "memory"); SWRITE(0, SE); __syncthreads();
  qkt(pA0, pA1, K_lds, qr, r32, hi); mask.apply(pA0, pA1, 0, wq, r32, hi); partialSM(pA0, pA1, m_reg, mnA, alA);
  SLOAD(SO, KVBLK); if constexpr (SD == 2) { if (2 < NT) SLOAD(SE, 2 * KVBLK); }
  SWAIT(); SWRITE(1, SO); __syncthreads();
  for (int j = 1; j + 1 < NT; j += 2) {
    SBAR(); qkt(pB0, pB1, K_lds + SHM_K, qr, r32, hi);
    finishSM(pA0, pA1, alA, l_reg, pa0, pa1, pa2, pa3); SBAR();
    if (!ODD || j + SD < NT) SLOAD(SO, (j + SD) * KVBLK); SBAR();
    pv_d0(o, vb0, pa0, pa1, pa2, pa3); mask.apply(pB0, pB1, j, wq, r32, hi); partialSM(pB0, pB1, m_reg, mnB, alB);
    __syncthreads(); SWAIT(); SWRITE(0, SE);
    RESC(alB); __syncthreads();
    SBAR(); qkt(pA0, pA1, K_lds, qr, r32, hi);
    finishSM(pB0, pB1, alB, l_reg, pa0, pa1, pa2, pa3); SBAR();
    if (SD == 1 || j + 3 < NT) SLOAD(SE, (j + 1 + SD) * KVBLK); SBAR();
    pv_d0(o, vb0 + (int)SHM_V, pa0, pa1, pa2, pa3); mask.apply(pA0, pA1, j + 1, wq, r32, hi); partialSM(pA0, pA1, m_reg, mnA, alA);
    __syncthreads(); SWAIT(); SWRITE(1, SO);
    RESC(alA); __syncthreads();
  }
  if constexpr (ODD) {
    finishSM(pA0, pA1, alA, l_reg, pa0, pa1, pa2, pa3); SBAR();
    pv_d0(o, vb0, pa0, pa1, pa2, pa3);
  } else {
  SBAR(); qkt(pB0, pB1, K_lds + SHM_K, qr, r32, hi);
  finishSM(pA0, pA1, alA, l_reg, pa0, pa1, pa2, pa3); SBAR();
  pv_d0(o, vb0, pa0, pa1, pa2, pa3); mask.apply(pB0, pB1, NT - 1, wq, r32, hi); partialSM(pB0, pB1, m_reg, mnB, alB);
  __syncthreads(); RESC(alB);
  finishSM(pB0, pB1, alB, l_reg, pa0, pa1, pa2, pa3); SBAR();
  pv_d0(o, vb0 + (int)SHM_V, pa0, pa1, pa2, pa3);
  }
  if (hi == 0) { li_l[r32] = l_reg; out.lse(wq * QBLK + r32, m_reg, l_reg); } asm volatile("s_waitcnt lgkmcnt(0)" ::: "memory");
  float rli[16];
#pragma unroll
  for (int r = 0; r < 16; ++r) rli[r] = __builtin_amdgcn_rcpf(li_l[crow(r, hi)]);
  LAS float* stg = (LAS float*)(lds + STG_OFF + wid * STG_WAVE);
#pragma unroll
  for (int half = 0; half < 2; ++half) {
#pragma unroll
    for (int r = 0; r < 16; ++r) {
      stg[crow(r, hi) * STG_STRIDE + r32] = o[half * 2][r] * rli[r]; stg[crow(r, hi) * STG_STRIDE + 32 + r32] = o[half * 2 + 1][r] * rli[r]; }
    asm volatile("s_waitcnt lgkmcnt(0)" ::: "memory");
#pragma unroll
    for (int i = 0; i < 4; ++i) { const int row = i * 8 + (lane >> 3), c8 = (lane & 7) * 8;
      const f32x4 v0 = *(const LAS f32x4*)(stg + row * STG_STRIDE + c8), v1 = *(const LAS f32x4*)(stg + row * STG_STRIDE + c8 + 4);
      out.store8(wq * QBLK + row, hsel * 128 + half * 64 + c8, v0, v1); }
    asm volatile("s_waitcnt lgkmcnt(0)" ::: "memory");
  }
#undef SLOAD
#undef SWRITE
#undef SWAIT
#undef RESC
}
}

#ifndef PH_A
#define PH_A 1
#endif
#ifndef PH_B
#define PH_B 1
#endif
#ifndef PH_C
#define PH_C 1
#endif
#ifndef PH_D
#define PH_D 1
#endif
#ifndef PH_G1
#define PH_G1 1
#endif
#ifndef PH_G2
#define PH_G2 1
#endif
#ifndef PH_G3
#define PH_G3 1
#endif

#ifndef PROBE
#define PROBE 0
#endif
#define REPS(k) ((PROBE == (k)) ? 2 : 1)
#define GSYNC() do { xcd_barrier(xbar); if (PROBE == 1) xcd_barrier(xbar); } while (0)

#ifndef TPROBE
#define TPROBE 0
#endif
#define TB(k) do { if (TPROBE == (k)) tp0 = __builtin_amdgcn_s_memrealtime(); } while (0)
#define TE(k) do { if (TPROBE == (k)) tpacc += __builtin_amdgcn_s_memrealtime() - tp0; } while (0)

#define XB_TMO      128
#define XB_XCNT(j)  (256  + 64 * (j))
#define XB_XSUB(j)  (1280 + 64 * (j))
#define XB_XGEN(j)  (2304 + 64 * (j))
#define XB_TOP      3328
#define XB_TOPGEN   3392
#define XCD_BAR_WORDS 3456
#define XB_SPIN_CAP (1u << 18)

__device__ __forceinline__ unsigned xb_ld(unsigned* p)              { return __hip_atomic_load(p, __ATOMIC_RELAXED, __HIP_MEMORY_SCOPE_AGENT); }
__device__ __forceinline__ unsigned xb_add(unsigned* p, unsigned v) { return __hip_atomic_fetch_add(p, v, __ATOMIC_RELAXED, __HIP_MEMORY_SCOPE_AGENT); }
__device__ __forceinline__ unsigned xb_xcc_id() { return (unsigned)__builtin_amdgcn_s_getreg((3 << 11) | 20) & 0xFu; }
#define XB_SPIN(cond, bar) do { unsigned _sp = 0; while (cond) { __builtin_amdgcn_s_sleep(1); \
    if ((++_sp & 255u) == 0u) { if (xb_ld(&(bar)[XB_TMO])) break; if (_sp > XB_SPIN_CAP) { atomicAdd(&(bar)[XB_TMO], 1u); break; } } } } while (0)

struct XcdBarrier {
    unsigned* bar; unsigned x;
    volatile LAS unsigned* st;
};

__device__ __forceinline__ XcdBarrier xcd_barrier_post(unsigned* bar, volatile LAS unsigned* st) {
    XcdBarrier b; b.bar = bar; b.x = xb_xcc_id(); b.st = st;
    if (threadIdx.x == 0) (void)xb_add(&bar[XB_XCNT(b.x)], 1u);
    return b;
}
__device__ __forceinline__ void xcd_barrier_complete(unsigned* bar, unsigned x, unsigned& nloc, unsigned& nx) {
    const unsigned G = gridDim.x * gridDim.y * gridDim.z;
    unsigned sum, cnt, mine, sp = 0u;
    for (;;) {
        sum = 0u; cnt = 0u; mine = 0u;
#pragma unroll
        for (unsigned j = 0; j < 16; ++j) { const unsigned c = xb_ld(&bar[XB_XCNT(j)]); sum += c; cnt += (c > 0u) ? 1u : 0u; mine = (j == x) ? c : mine; }
        if (sum == G) break;
        __builtin_amdgcn_s_sleep(1);
        if ((++sp & 255u) == 0u) { if (xb_ld(&bar[XB_TMO])) break; if (sp > XB_SPIN_CAP) { atomicAdd(&bar[XB_TMO], 1u); break; } }
    }
    nloc = mine > 0u ? mine : 1u; nx = cnt > 0u ? cnt : 1u;
}

__device__ __forceinline__ void xcd_barrier(const XcdBarrier& b) {
    asm volatile("s_waitcnt vmcnt(0)" ::: "memory");
    __syncthreads();
    if (threadIdx.x == 0) {
        unsigned* bar = b.bar;
        __builtin_amdgcn_s_waitcnt(0);
        unsigned nloc = b.st[0], nx = b.st[1];
        if (nloc == 0u) { xcd_barrier_complete(bar, b.x, nloc, nx); b.st[0] = nloc; b.st[1] = nx; }
        const unsigned old = xb_add(&bar[XB_XSUB(b.x)], 1u);
        const unsigned gen = old / nloc;
        if (old + 1u == (gen + 1u) * nloc) {
            __builtin_amdgcn_fence(__ATOMIC_RELEASE, "agent");
            asm volatile("s_waitcnt vmcnt(0)" ::: "memory");
            const unsigned og = xb_add(&bar[XB_TOP], 1u);
            const unsigned tg = og / nx;
            if (og + 1u == (tg + 1u) * nx) xb_add(&bar[XB_TOPGEN], 1u);
            else XB_SPIN(xb_ld(&bar[XB_TOPGEN]) == tg, bar);
            __builtin_amdgcn_fence(__ATOMIC_ACQUIRE, "agent");
            xb_add(&bar[XB_XGEN(b.x)], 1u);
            asm volatile("s_waitcnt vmcnt(0)" ::: "memory");
        } else {
            XB_SPIN(xb_ld(&bar[XB_XGEN(b.x)]) == gen, bar);
            __builtin_amdgcn_fence(__ATOMIC_ACQUIRE, "agent");
            asm volatile("s_waitcnt vmcnt(0)" ::: "memory");
        }
    }
    __syncthreads();
}

struct Params {
  const float *x, *c, *norm_g, *w_ada, *b_ada, *w_in, *a_sink, *c_q_norm, *c_k_norm, *d_rel_bias, *w_gm, *w_branch, *w_out, *final_g;
  float* out; unsigned char* ws;
};
constexpr int LDS_BYTES = 147456, XST_OFF = 146432;

__device__ __forceinline__ float shx(float v, int o, int lane) { return __builtin_bit_cast(float, __builtin_amdgcn_ds_bpermute((lane ^ o) << 2, __builtin_bit_cast(int, v))); }

__device__ __forceinline__ void t_decode(int it, const Params& p, bf16_t* WT1, bf16_t* WT2, bf16_t* WT3, int lane, const float*& src, int& N, bf16_t*& dst) {
  constexpr int I_IN = 32 * (INC / 32), I_GM = 32 * (GMC / 32), I_BR = 4 * 8 * 64, I_OUT = 32 * 64, I_L = I_IN + I_GM + I_BR + I_OUT;
  const int l = it / I_L; int r = it % I_L; const float* W; bf16_t* WT; int row_off = 0, coff = 0, perm = 0;
  if (r < I_IN) { W = p.w_in + (size_t)l * DM * INC; N = INC; WT = WT1 + (size_t)l * N1 * DM; perm = 1; }
  else { r -= I_IN;
    if (r < I_GM) { W = p.w_gm + (size_t)l * DM * GMC; N = GMC; WT = WT1 + (size_t)l * N1 * DM; row_off = INC; perm = 2; }
    else { r -= I_GM;
      if (r < I_BR) { const int n = r >> 9; r &= 511; W = p.w_branch + (size_t)(l * 4 + n) * 512 * DM; N = DM; WT = WT2 + (size_t)l * DM * DM; coff = n * 512; }
      else { r -= I_BR; W = p.w_out + (size_t)l * DM * DM; N = DM; WT = WT3 + (size_t)l * DM * DM; } } }
  const int nblk = N >> 5, kb = r / nblk, nb = r % nblk, k0 = 64 * kb, c = lane & 7, n = 32 * nb + 4 * (lane >> 3);
  src = W + (size_t)(k0 + 8 * c) * N + n;
  dst = WT + (size_t)(row_off + (perm == 1 ? pg8::g1_row(n) : (perm == 2 ? pg8::gm_row(n) : n))) * DM + coff + k0 + 8 * c;
}

__global__ void __launch_bounds__(512) mega_fwd(Params p) {
  extern __shared__ __attribute__((aligned(16))) unsigned char lds_raw[];
  LAS unsigned char* lds = (LAS unsigned char*)lds_raw;
  cg::grid_group grid = cg::this_grid();
  const int G = gridDim.x, cb = blockIdx.x, NGW = G * 8;
  volatile LAS unsigned* xst = (volatile LAS unsigned*)(lds + XST_OFF);
  if (threadIdx.x < 2) xst[threadIdx.x] = 0u;
  __syncthreads();
  if (blockIdx.x == 0) for (int i = threadIdx.x; i < 4096; i += 512) ((unsigned*)(p.ws + WS_BAR))[i] = 0u;
  XcdBarrier xbar;
  unsigned long long tp0 = 0, tpacc = 0; (void)tp0; (void)tpacc;
  TB(1);
#define PHASE_IDS int tid = threadIdx.x; asm volatile("" : "+v"(tid)); const int lane = tid & 63, wave = __builtin_amdgcn_readfirstlane(tid >> 6), gw = cb * 8 + wave; (void)lane; (void)gw;
  unsigned char* ws = p.ws;
  bf16_t* WT1 = (bf16_t*)(ws + WS_WT1); bf16_t* WT2 = (bf16_t*)(ws + WS_WT2); bf16_t* WT3 = (bf16_t*)(ws + WS_WT3);
  bf16_t* HB = (bf16_t*)(ws + WS_H); bf16_t* YB = HB; bf16_t* QKVG = (bf16_t*)(ws + WS_QKVG); bf16_t* MERGED = QKVG; bf16_t* MG = (bf16_t*)(ws + WS_MG);
  bf16_t* PO = (bf16_t*)(ws + WS_PO); float* PLSE = (float*)(ws + WS_PLSE); float* ADA = (float*)(ws + WS_ADA); bf16_t* XB = (bf16_t*)(ws + WS_XB);

  {
    PHASE_IDS
    LAS float* sc = (LAS float*)lds; LAS float* red = (LAS float*)(lds + 16384);
    for (int i = tid; i < NB * DM; i += 512) { const float v = p.c[i]; sc[i] = v * sigmoidf_(v); }
    __syncthreads();
    for (int u = cb; u < DEPTH * 64; u += G) {
      const int l = u >> 6, jb = u & 63;
      if (tid < 384) { const int qd = tid % 24, kg = tid / 24;
        const float* W = p.w_ada + (size_t)l * DM * (3 * DM) + jb * 96 + 4 * qd + (size_t)(kg * 128) * (3 * DM);
        f32x4 a0 = {0.f, 0.f, 0.f, 0.f}, a1 = {0.f, 0.f, 0.f, 0.f};
#pragma unroll 8
        for (int k = 0; k < 128; ++k) { const f32x4 w = __builtin_nontemporal_load((const f32x4*)(W + (size_t)k * (3 * DM))); a0 += w * sc[kg * 128 + k]; a1 += w * sc[DM + kg * 128 + k]; }
        *(LAS f32x4*)(red + (kg * 2 + 0) * 96 + 4 * qd) = a0; *(LAS f32x4*)(red + (kg * 2 + 1) * 96 + 4 * qd) = a1; }
      __syncthreads();
      if (tid < 192) { const int b = tid / 96, cc = tid % 96; float s = 0.f;
#pragma unroll
        for (int w = 0; w < 16; ++w) s += red[(w * 2 + b) * 96 + cc];
        ADA[(size_t)(l * NB + b) * (3 * DM) + jb * 96 + cc] = s + p.b_ada[l * 3 * DM + jb * 96 + cc]; }
      __syncthreads();
    }
    constexpr int T_TOT = DEPTH * (32 * (INC / 32) + 32 * (GMC / 32) + 4 * 8 * 64 + 32 * 64);
    for (int it0 = gw; it0 < T_TOT; it0 += 2 * NGW) {
      const float* s0; const float* s1; int n0_, n1_; bf16_t* d0; bf16_t* d1;
      const bool has1 = it0 + NGW < T_TOT;
      t_decode(it0, p, WT1, WT2, WT3, lane, s0, n0_, d0); t_decode(has1 ? it0 + NGW : it0, p, WT1, WT2, WT3, lane, s1, n1_, d1);
      f32x4 v0[8], v1[8];
#pragma unroll
      for (int i = 0; i < 8; ++i) { v0[i] = __builtin_nontemporal_load((const f32x4*)(s0 + (size_t)i * n0_)); v1[i] = __builtin_nontemporal_load((const f32x4*)(s1 + (size_t)i * n1_)); }
#pragma unroll
      for (int e = 0; e < 4; ++e) { u32x4 o; o.x = cvt_pk_bf16(v0[0][e], v0[1][e]); o.y = cvt_pk_bf16(v0[2][e], v0[3][e]); o.z = cvt_pk_bf16(v0[4][e], v0[5][e]); o.w = cvt_pk_bf16(v0[6][e], v0[7][e]);
        *(u32x4*)(d0 + (size_t)e * DM) = o; }
      if (has1) {
#pragma unroll
        for (int e = 0; e < 4; ++e) { u32x4 o; o.x = cvt_pk_bf16(v1[0][e], v1[1][e]); o.y = cvt_pk_bf16(v1[2][e], v1[3][e]); o.z = cvt_pk_bf16(v1[4][e], v1[5][e]); o.w = cvt_pk_bf16(v1[6][e], v1[7][e]);
          *(u32x4*)(d1 + (size_t)e * DM) = o; } }
    }
  }
  grid.sync();
  xbar = xcd_barrier_post((unsigned*)(p.ws + WS_BAR), xst);
  TE(1);

#pragma unroll 1
  for (int l = 0; l < DEPTH; ++l) {
    TB(2);
    for (int rep = 0; rep < REPS(4); ++rep) { PHASE_IDS
    for (int row0 = gw; row0 < NTOK; row0 += 4 * NGW) {
      f32x4 v[4][8]; float ss[4];
      if (l == 0) {
#pragma unroll
        for (int k = 0; k < 4; ++k) { const int row = (row0 + k * NGW < NTOK) ? row0 + k * NGW : row0;
          const f32x4* xr = (const f32x4*)(p.x + (size_t)row * DM) + 2 * lane;
#pragma unroll
          for (int j = 0; j < 4; ++j) { v[k][2 * j] = xr[128 * j]; v[k][2 * j + 1] = xr[128 * j + 1]; } }
      } else {
#pragma unroll
        for (int k = 0; k < 4; ++k) { const int row = (row0 + k * NGW < NTOK) ? row0 + k * NGW : row0;
          const u32x4* xr = (const u32x4*)(XB + (size_t)row * DM) + lane;
#pragma unroll
          for (int j = 0; j < 4; ++j) { const u32x4 r = xr[64 * j];
            v[k][2 * j] = (f32x4){bf_lo(r.x), bf_hi(r.x), bf_lo(r.y), bf_hi(r.y)}; v[k][2 * j + 1] = (f32x4){bf_lo(r.z), bf_hi(r.z), bf_lo(r.w), bf_hi(r.w)}; } }
      }
#pragma unroll
      for (int k = 0; k < 4; ++k) { float s = 0.f;
#pragma unroll
        for (int j = 0; j < 8; ++j) s += (v[k][j].x * v[k][j].x + v[k][j].y * v[k][j].y) + (v[k][j].z * v[k][j].z + v[k][j].w * v[k][j].w);
        ss[k] = s; }
#pragma unroll
      for (int o = 1; o < 64; o <<= 1) {
#pragma unroll
        for (int k = 0; k < 4; ++k) ss[k] += shx(ss[k], o, lane); }
#pragma unroll
      for (int k = 0; k < 4; ++k) { const int row = row0 + k * NGW; if (row < NTOK) {
        const float rstd = rsqrtf(ss[k] * (1.f / DM) + EPS);
        const float* ad = ADA + (size_t)(l * NB + (row >> 13)) * (3 * DM);
        u32x4* o16 = (u32x4*)(HB + (size_t)row * DM) + lane;
#pragma unroll
        for (int j = 0; j < 4; ++j) { const int col = (64 * j + lane) * 8; u32x4 w;
#pragma unroll
          for (int hh = 0; hh < 2; ++hh) { const int cc = col + 4 * hh;
            const f32x4 g = *(const f32x4*)(p.norm_g + l * DM + cc), sh = *(const f32x4*)(ad + cc), scl = *(const f32x4*)(ad + DM + cc);
            const f32x4 y = (v[k][2 * j + hh] * rstd * g) * (scl + 1.0f) + sh;
            if (hh == 0) { w.x = cvt_pk_bf16(y.x, y.y); w.y = cvt_pk_bf16(y.z, y.w); } else { w.z = cvt_pk_bf16(y.x, y.y); w.w = cvt_pk_bf16(y.z, y.w); } }
          o16[64 * j] = w; } } }
    } }
    GSYNC();
    TE(2); TB(3);
#if PH_G1
    for (int rep = 0; rep < REPS(2); ++rep) { pg8::Gemm g{HB, WT1 + (size_t)l * N1 * DM, DM, DM}; pg8::Order S; S.init(NTOK, N1, G, cb, 0, 1);
      pg8::EpiG1 E{QKVG, MG}; pg8::gemm_phase<pg8::EpiG1>(lds, g, S, E); }
#endif
    GSYNC();
    TE(3); TB(4);
    for (int rep = 0; rep < REPS(3); ++rep) { PHASE_IDS
    for (int it0 = gw; it0 < NTOK * 6 / 8; it0 += 2 * NGW) {
      const int j8 = lane & 7, part = j8 >> 2, sub = j8 & 3, e0 = part * 64 + 8 * sub;
      const f32x4 iv0 = *(const f32x4*)(INV32 + 8 * sub), iv1 = *(const f32x4*)(INV32 + 8 * sub + 4);
      u32x4 ra[2], rb[2]; bf16_t* bp[2]; int tk[2], isk_[2]; bool act[2];
#pragma unroll
      for (int k = 0; k < 2; ++k) { const int it = it0 + k * NGW; act[k] = it < NTOK * 6 / 8; const int H = (act[k] ? it : it0) * 8 + (lane >> 3);
        const int tok = H / 6, h6 = H - tok * 6; tk[k] = tok; isk_[k] = h6 >= 4;
        bp[k] = QKVG + (size_t)tok * INC + (h6 >= 4 ? KC + (h6 - 4) * 128 : QC + h6 * 128) + e0;
        ra[k] = *(const u32x4*)bp[k]; rb[k] = *(const u32x4*)(bp[k] + 32); }
#pragma unroll
      for (int k = 0; k < 2; ++k) { const int s = tk[k] & (SEQ - 1); const float pos = part ? (float)(s & 63) : (float)(s >> 6);
        float a[8] = {bf_lo(ra[k].x), bf_hi(ra[k].x), bf_lo(ra[k].y), bf_hi(ra[k].y), bf_lo(ra[k].z), bf_hi(ra[k].z), bf_lo(ra[k].w), bf_hi(ra[k].w)};
        float b[8] = {bf_lo(rb[k].x), bf_hi(rb[k].x), bf_lo(rb[k].y), bf_hi(rb[k].y), bf_lo(rb[k].z), bf_hi(rb[k].z), bf_lo(rb[k].w), bf_hi(rb[k].w)};
        float ss = 0.f;
#pragma unroll
        for (int j = 0; j < 8; ++j) ss += a[j] * a[j] + b[j] * b[j];
        ss += shx(ss, 1, lane); ss += shx(ss, 2, lane); ss += shx(ss, 4, lane);
        const float rstd = rsqrtf(ss * (1.f / 128.f) + EPS); const float* wn = (isk_[k] ? p.c_k_norm : p.c_q_norm) + l * 128 + e0;
        const f32x4 wa0 = *(const f32x4*)wn, wa1 = *(const f32x4*)(wn + 4), wb0 = *(const f32x4*)(wn + 32), wb1 = *(const f32x4*)(wn + 36);
        float oa[8], ob[8];
#pragma unroll
        for (int j = 0; j < 8; ++j) { const float av = a[j] * rstd * (j < 4 ? wa0[j & 3] : wa1[j & 3]), bv = b[j] * rstd * (j < 4 ? wb0[j & 3] : wb1[j & 3]);
          const float ang = pos * (j < 4 ? iv0[j & 3] : iv1[j & 3]); double rev = (double)ang * 0.15915494309189535; rev -= __builtin_rint(rev);
          const float fr = (float)rev, sn = __builtin_amdgcn_sinf(fr), cs = __builtin_amdgcn_cosf(fr);
          oa[j] = av * cs - bv * sn; ob[j] = bv * cs + av * sn; }
        u32x4 wa, wb; wa.x = cvt_pk_bf16(oa[0], oa[1]); wa.y = cvt_pk_bf16(oa[2], oa[3]); wa.z = cvt_pk_bf16(oa[4], oa[5]); wa.w = cvt_pk_bf16(oa[6], oa[7]);
        wb.x = cvt_pk_bf16(ob[0], ob[1]); wb.y = cvt_pk_bf16(ob[2], ob[3]); wb.z = cvt_pk_bf16(ob[4], ob[5]); wb.w = cvt_pk_bf16(ob[6], ob[7]);
        if (act[k]) { *(u32x4*)bp[k] = wa; *(u32x4*)(bp[k] + 32) = wb; } }
    }
    for (int u = cb; u < 1024; u += G) {
#if PH_A
      if (u < 256) {
        const int x = u & 7, b = (x >> 2) & 1, kvh = (x >> 1) & 1, qb = (x & 1) * 32 + ((u >> 3) & 31), q0 = qb * 128;
        int lo = q0 - 128; if (lo < 0) lo = 0; int hi = q0 + 256; if (hi > SEQ) hi = SEQ;
        const size_t t0 = (size_t)b * SEQ + q0, k0 = (size_t)b * SEQ + lo;
        att::MaskBand mk{lo - q0, 128}; att::OutGated og{YB + t0 * DM + 0 * 512 + (2 * kvh) * 128, QKVG + t0 * INC + GA + (2 * kvh) * 128};
        att::attn_unit<att::MaskBand, att::OutGated, 2, true>(QKVG + t0 * INC + QA + (2 * kvh) * 128, QKVG + k0 * INC + KA + kvh * 128, QKVG + k0 * INC + VA + kvh * 128, INC, INC, (hi - lo) >> 6,
                       p.a_sink[l * 4 + 2 * kvh] * (1.0f / att::SCALE), 1.0f, mk, og, (LAS char*)lds, p.a_sink[l * 4 + 2 * kvh + 1] * (1.0f / att::SCALE));
      } else
#endif
#if PH_B
      if (u >= 256 && u < 768) {
        const int v = u - 256, grp = v >> 8, b = (v >> 2) & 1, h = v & 3, blk = (v >> 3) & 31;
        if (grp == 0) {
          const int q0 = blk * 256; int lo = q0 - 256; if (lo < 0) lo = 0; int hi = q0 + 512; if (hi > SEQ) hi = SEQ;
          const size_t t0 = (size_t)b * SEQ + q0, k0 = (size_t)b * SEQ + lo;
          att::MaskBand2 mk{lo - q0}; att::OutPartial op{PO + ((size_t)0 * NTOK + t0) * 512 + h * 128, PLSE + ((size_t)0 * NTOK + t0) * 4 + h, 1};
          att::attn_unit(QKVG + t0 * INC + QB_ + h * 128, QKVG + k0 * INC + KB_ + h * 128, QKVG + k0 * INC + VB_ + h * 128, INC, INC, (hi - lo) >> 6,
                         att::MFLOOR, 0.0f, mk, op, (LAS char*)lds);
        } else {
          const int pt = 2, dsh = 4, dil = 16, L = SEQ >> dsh, bpr = L >> 8;
          const int r = blk / bpr, lb = blk % bpr, l0 = lb * 256;
          int lo = l0 - 64; if (lo < 0) lo = 0; int hi = l0 + 320; if (hi > L) hi = L;
          const size_t t0 = (size_t)b * SEQ + r + (size_t)dil * l0, k0 = (size_t)b * SEQ + r + (size_t)dil * lo;
          att::MaskBand mk{lo - l0, 64}; att::OutPartial op{PO + ((size_t)pt * NTOK + t0) * 512 + h * 128, PLSE + ((size_t)pt * NTOK + t0) * 4 + h, dil};
          att::attn_unit<att::MaskBand, att::OutPartial, 2, false, true>(QKVG + t0 * INC + QB_ + h * 128, QKVG + k0 * INC + KB_ + h * 128, QKVG + k0 * INC + VB_ + h * 128, INC * dil, INC * dil, (hi - lo) >> 6,
                         att::MFLOOR, 0.0f, mk, op, (LAS char*)lds);
        }
      } else
#endif
#if PH_D
      if (u >= 768) {
        const int v = u - 768, b = (v >> 2) & 1, h = v & 3, blk = (v >> 3) & 31, r0 = blk * 4;
        int lo = r0 - 4; lo = lo < 0 ? 0 : (lo > 120 ? 120 : lo); int hi = r0 + 3 - 4; hi = (hi < 0 ? 0 : (hi > 120 ? 120 : hi)) + 8;
        LAS float* tab = (LAS float*)(lds + att::TAB_OFF);
        __syncthreads();
        for (int i = tid; i < 15 * 128; i += 512) { const int dr = i >> 7, dc = (i & 127) - 63;
          tab[i] = (dc >= -15 && dc <= 15) ? p.d_rel_bias[(size_t)(l * 4 + h) * 465 + dr * 31 + dc + 15] * (1.0f / att::SCALE) : 0.f; }
        __syncthreads();
        const size_t t0 = (size_t)b * SEQ + r0 * 64, k0 = (size_t)b * SEQ + lo * 64;
        att::MaskNA mk{r0, lo, tab}; att::OutGated og{YB + t0 * DM + 3 * 512 + h * 128, QKVG + t0 * INC + GD + h * 128};
if ((hi - lo) & 1)         att::attn_unit<att::MaskNA, att::OutGated, 2, false, true>(QKVG + t0 * INC + QD + h * 128, QKVG + k0 * INC + KD + h * 128, QKVG + k0 * INC + VD + h * 128, INC, INC, hi - lo,
                       att::MFLOOR, 0.0f, mk, og, (LAS char*)lds);
        else         att::attn_unit<att::MaskNA, att::OutGated, 2>(QKVG + t0 * INC + QD + h * 128, QKVG + k0 * INC + KD + h * 128, QKVG + k0 * INC + VD + h * 128, INC, INC, hi - lo,
                       att::MFLOOR, 0.0f, mk, og, (LAS char*)lds);
      }
#endif
      {}
    } }
    GSYNC();
    TE(4); TB(5);
    for (int rep = 0; rep < REPS(4); ++rep) { PHASE_IDS
    for (int tok0 = gw; tok0 < NTOK; tok0 += 4 * NGW) {
      const int h = lane >> 4, c8 = (lane & 15) * 8;
      float ls[4][2]; u32x4 ov[4][2], gg[4];
#pragma unroll
      for (int k = 0; k < 4; ++k) { const int tok = (tok0 + k * NGW < NTOK) ? tok0 + k * NGW : tok0;
#pragma unroll
        for (int ps = 0; ps < 2; ++ps) { const int pt = 2 * ps; ls[k][ps] = PLSE[((size_t)pt * NTOK + tok) * 4 + h]; ov[k][ps] = *(const u32x4*)(PO + ((size_t)pt * NTOK + tok) * 512 + h * 128 + c8); }
        gg[k] = *(const u32x4*)(QKVG + (size_t)tok * INC + GB_ + h * 128 + c8); }
#pragma unroll
      for (int k = 0; k < 4; ++k) { const int tok = tok0 + k * NGW; if (tok < NTOK) {
        const float mx = fmaxf(ls[k][0], ls[k][1]); float w0 = __expf(ls[k][0] - mx), w1 = __expf(ls[k][1] - mx);
        const float rs = 1.0f / (w0 + w1); w0 *= rs; w1 *= rs;
        u32x4 y;
#define CMB(F) cvt_pk_bf16((w0 * bf_lo(ov[k][0].F) + w1 * bf_lo(ov[k][1].F)) * bf_lo(gg[k].F), (w0 * bf_hi(ov[k][0].F) + w1 * bf_hi(ov[k][1].F)) * bf_hi(gg[k].F))
        y.x = CMB(x); y.y = CMB(y); y.z = CMB(z); y.w = CMB(w);
#undef CMB
        *(u32x4*)(YB + (size_t)tok * DM + 1 * 512 + h * 128 + c8) = y; } }
    } }
#if PH_C
    for (int rep = 0; rep < REPS(3) * REPS(6); ++rep)
    for (int u = cb; u < 256; u += G) {
      const int xcd = u & 7, idx = u >> 3, pair = xcd >> 1, b = pair >> 1, kvh = pair & 1, hq = kvh * 2 + (xcd & 1), q0 = idx * 256;
      const size_t t0 = (size_t)b * SEQ + q0, k0 = (size_t)b * SEQ;
      att::MaskNone mk; att::OutGated og{YB + t0 * DM + 2 * 512 + hq * 128, QKVG + t0 * INC + GC + hq * 128};
      att::attn_unit(QKVG + t0 * INC + QC + hq * 128, QKVG + k0 * INC + KC + kvh * 128, QKVG + k0 * INC + VC + kvh * 128, INC, INC, SEQ / 64,
                     att::MFLOOR, 0.0f, mk, og, (LAS char*)lds);
    }
#endif
    GSYNC();
    TE(5); TB(6);
#if PH_G2
    for (int rep = 0; rep < REPS(5); ++rep) { pg8::Gemm g{YB, WT2 + (size_t)l * DM * DM, DM, DM}; pg8::Order S; S.init(NTOK, DM, G, cb, 0);
      pg8::EpiG2 E{MG, MERGED}; pg8::gemm_phase<pg8::EpiG2>(lds, g, S, E); }
#endif
    GSYNC();
    TE(6); TB(7);
#if PH_G3
    { pg8::Gemm g{MERGED, WT3 + (size_t)l * DM * DM, DM, DM}; pg8::Order S; S.init(NTOK, DM, G, cb, 0);
      pg8::EpiG3 E{(l == 0) ? p.x : (const float*)nullptr, XB, ADA + (size_t)(l * NB) * (3 * DM) + 2 * DM}; pg8::gemm_phase<pg8::EpiG3>(lds, g, S, E); }
#endif
    GSYNC();
    TE(7);
  }
  TB(8);
  { PHASE_IDS
  for (int row0 = gw; row0 < NTOK; row0 += 4 * NGW) {
    f32x4 v[4][8]; float ss[4];
#pragma unroll
    for (int k = 0; k < 4; ++k) { const int row = (row0 + k * NGW < NTOK) ? row0 + k * NGW : row0;
      const u32x4* xr = (const u32x4*)(XB + (size_t)row * DM) + lane;
#pragma unroll
      for (int j = 0; j < 4; ++j) { const u32x4 r = xr[64 * j];
        v[k][2 * j] = (f32x4){bf_lo(r.x), bf_hi(r.x), bf_lo(r.y), bf_hi(r.y)}; v[k][2 * j + 1] = (f32x4){bf_lo(r.z), bf_hi(r.z), bf_lo(r.w), bf_hi(r.w)}; } }
#pragma unroll
    for (int k = 0; k < 4; ++k) { float s = 0.f;
#pragma unroll
      for (int j = 0; j < 8; ++j) s += (v[k][j].x * v[k][j].x + v[k][j].y * v[k][j].y) + (v[k][j].z * v[k][j].z + v[k][j].w * v[k][j].w);
      ss[k] = s; }
#pragma unroll
    for (int o = 1; o < 64; o <<= 1) {
#pragma unroll
      for (int k = 0; k < 4; ++k) ss[k] += shx(ss[k], o, lane); }
#pragma unroll
    for (int k = 0; k < 4; ++k) { const int row = row0 + k * NGW; if (row < NTOK) {
      const float rstd = rsqrtf(ss[k] * (1.f / DM) + EPS);
      f32x4* xw = (f32x4*)(p.out + (size_t)row * DM) + 2 * lane;
#pragma unroll
      for (int j = 0; j < 4; ++j) { const int col = (64 * j + lane) * 8;
        const f32x4 g0 = *(const f32x4*)(p.final_g + col), g1 = *(const f32x4*)(p.final_g + col + 4);
        __builtin_nontemporal_store(v[k][2 * j] * rstd * g0, xw + 128 * j); __builtin_nontemporal_store(v[k][2 * j + 1] * rstd * g1, xw + 128 * j + 1); } } }
  } }
  if (TPROBE != 0) { __syncthreads(); TE(8);
    if (blockIdx.x == 0 && threadIdx.x == 0) { const unsigned long long ts = __builtin_amdgcn_s_memrealtime(); while (__builtin_amdgcn_s_memrealtime() - ts < tpacc) __builtin_amdgcn_s_sleep(32); } }
}

extern "C" void kernel_launch(void* const* d_in, const int* in_sizes, int n_in, void* d_out, int out_size, void* d_ws, size_t ws_size, hipStream_t stream) {
  static int grid_blocks = 0;
  if (grid_blocks == 0) {
    if (n_in != 14 || out_size != NTOK * DM || ws_size < WS_END) { fprintf(stderr, "kernel_launch: unexpected shapes (n_in %d out %d ws %zu need %zu)\n", n_in, out_size, ws_size, (size_t)WS_END); grid_blocks = -1; return; }
    int dev = 0, cus = 0, per_cu = 0;
    hipGetDevice(&dev); hipDeviceGetAttribute(&cus, hipDeviceAttributeMultiprocessorCount, dev);
    if (hipFuncSetAttribute((const void*)mega_fwd, hipFuncAttributeMaxDynamicSharedMemorySize, LDS_BYTES) != hipSuccess) { fprintf(stderr, "kernel_launch: hipFuncSetAttribute failed\n"); grid_blocks = -1; return; }
    hipOccupancyMaxActiveBlocksPerMultiprocessor(&per_cu, (const void*)mega_fwd, 512, LDS_BYTES);
    (void)hipGetLastError();
    if (per_cu < 1) per_cu = 1;
    grid_blocks = cus * 1;
  }
  if (grid_blocks < 0) return;
  Params p{};
  p.x = (const float*)d_in[0]; p.c = (const float*)d_in[1]; p.norm_g = (const float*)d_in[2]; p.w_ada = (const float*)d_in[3]; p.b_ada = (const float*)d_in[4];
  p.w_in = (const float*)d_in[5]; p.a_sink = (const float*)d_in[6]; p.c_q_norm = (const float*)d_in[7]; p.c_k_norm = (const float*)d_in[8]; p.d_rel_bias = (const float*)d_in[9];
  p.w_gm = (const float*)d_in[10]; p.w_branch = (const float*)d_in[11]; p.w_out = (const float*)d_in[12]; p.final_g = (const float*)d_in[13];
  p.out = (float*)d_out; p.ws = (unsigned char*)d_ws;
  void* args[] = {&p};
  hipError_t e = hipLaunchCooperativeKernel((const void*)mega_fwd, dim3(grid_blocks), dim3(512), args, LDS_BYTES, stream);
  if (e != hipSuccess) fprintf(stderr, "cooperative launch failed: %s (grid %d)\n", hipGetErrorString(e), grid_blocks);
}
```

```cpp
#include <hip/hip_runtime.h>
#include <hip/hip_bf16.h>
#include <hip/hip_cooperative_groups.h>
#include <cstdio>
#include <cstdint>
#include <cmath>
namespace cg = cooperative_groups;

#define LAS __attribute__((address_space(3)))
typedef unsigned short bf16_t;
typedef short bf16x8 __attribute__((ext_vector_type(8)));
typedef short s16x4 __attribute__((ext_vector_type(4)));
typedef float f32x4 __attribute__((ext_vector_type(4)));
typedef float f32x2 __attribute__((ext_vector_type(2)));
typedef float f32x16 __attribute__((ext_vector_type(16)));
typedef unsigned u32x4 __attribute__((ext_vector_type(4)));
typedef unsigned u32x2 __attribute__((ext_vector_type(2)));

__constant__ float INV64[64] = {1.000000000e+00f, 8.659643531e-01f, 7.498942018e-01f, 6.493816376e-01f, 5.623413324e-01f, 4.869675338e-01f, 4.216965139e-01f, 3.651741147e-01f, 3.162277639e-01f, 2.738419771e-01f, 2.371373773e-01f, 2.053525001e-01f, 1.778279394e-01f, 1.539926529e-01f, 1.333521456e-01f, 1.154781953e-01f, 1.000000015e-01f, 8.659642935e-02f, 7.498942316e-02f, 6.493816525e-02f, 5.623413250e-02f, 4.869675264e-02f, 4.216964915e-02f, 3.651741147e-02f, 3.162277490e-02f, 2.738419548e-02f, 2.371373773e-02f, 2.053525113e-02f, 1.778279431e-02f, 1.539926510e-02f, 1.333521400e-02f, 1.154781971e-02f, 9.999999776e-03f, 8.659643121e-03f, 7.498942316e-03f, 6.493816152e-03f, 5.623413250e-03f, 4.869675264e-03f, 4.216964822e-03f, 3.651741194e-03f, 3.162277630e-03f, 2.738419687e-03f, 2.371373819e-03f, 2.053525066e-03f, 1.778279431e-03f, 1.539926510e-03f, 1.333521446e-03f, 1.154782018e-03f, 1.000000047e-03f, 8.659643354e-04f, 7.498941850e-04f, 6.493816036e-04f, 5.623413017e-04f, 4.869675322e-04f, 4.216965172e-04f, 3.651741135e-04f, 3.162277571e-04f, 2.738419571e-04f, 2.371373703e-04f, 2.053525095e-04f, 1.778279402e-04f, 1.539926598e-04f, 1.333521504e-04f, 1.154782003e-04f};
__constant__ float INV32[32] = {1.000000000e+00f, 7.498942018e-01f, 5.623413324e-01f, 4.216965139e-01f, 3.162277639e-01f, 2.371373773e-01f, 1.778279394e-01f, 1.333521456e-01f, 1.000000015e-01f, 7.498942316e-02f, 5.623413250e-02f, 4.216964915e-02f, 3.162277490e-02f, 2.371373773e-02f, 1.778279431e-02f, 1.333521400e-02f, 9.999999776e-03f, 7.498942316e-03f, 5.623413250e-03f, 4.216964822e-03f, 3.162277630e-03f, 2.371373819e-03f, 1.778279431e-03f, 1.333521446e-03f, 1.000000047e-03f, 7.498941850e-04f, 5.623413017e-04f, 4.216965172e-04f, 3.162277571e-04f, 2.371373703e-04f, 1.778279402e-04f, 1.333521504e-04f};

constexpr int DM = 2048, SEQ = 8192, NB = 2, NTOK = NB * SEQ, DEPTH = 4;
constexpr int INC = 7168, GMC = 8192, N1 = INC + GMC;
constexpr float EPS = 1e-6f;
constexpr int QA = 0, KA = 512, VA = 768, GA = 1024, QB_ = 1536, KB_ = 2048, VB_ = 2560, GB_ = 3072, QC = 3584, KC = 4096, VC = 4352, GC = 4608, QD = 5120, KD = 5632, VD = 6144, GD = 6656;

constexpr size_t WS_WT1 = 0;
constexpr size_t WS_WT2 = WS_WT1 + (size_t)DEPTH * N1 * DM * 2;
constexpr size_t WS_WT3 = WS_WT2 + (size_t)DEPTH * DM * DM * 2;
constexpr size_t WS_H = WS_WT3 + (size_t)DEPTH * DM * DM * 2;
constexpr size_t WS_QKVG = WS_H + (size_t)NTOK * DM * 2;
constexpr size_t WS_MG = WS_QKVG + (size_t)NTOK * INC * 2;
constexpr size_t WS_PO = WS_MG + (size_t)NTOK * GMC * 2;
constexpr size_t WS_PLSE = WS_PO + (size_t)3 * NTOK * 512 * 2;
constexpr size_t WS_ADA = WS_PLSE + (size_t)3 * NTOK * 4 * 4;
constexpr size_t WS_BAR = WS_ADA + (size_t)DEPTH * NB * 3 * DM * 4;
constexpr size_t WS_XB = WS_BAR + 16384;
constexpr size_t WS_END = WS_XB + (size_t)NTOK * DM * 2;

typedef __bf16 bf16x2_t __attribute__((ext_vector_type(2)));
__device__ __forceinline__ unsigned cvt_pk_bf16(float lo, float hi) { f32x2 v = {lo, hi}; bf16x2_t b = __builtin_convertvector(v, bf16x2_t); return __builtin_bit_cast(unsigned, b); }
__device__ __forceinline__ float bf_lo(unsigned w) { return __uint_as_float(w << 16); }
__device__ __forceinline__ float bf_hi(unsigned w) { return __uint_as_float(w & 0xffff0000u); }
__device__ __forceinline__ float bf2f(bf16_t v) { return __uint_as_float(((unsigned)v) << 16); }
__device__ __forceinline__ bf16_t f2bf(float f) { return (bf16_t)(cvt_pk_bf16(f, 0.f) & 0xffffu); }
__device__ __forceinline__ float sigmoidf_(float v) { return __builtin_amdgcn_rcpf(1.0f + __expf(-v)); }

namespace pg8 {
constexpr int BM = 256, BK = 64, HALF = 128, HTB = HALF * BK * 2, STAGE_BYTES = 8 * HTB, NXCD = 8, WGM = 8;
__host__ __device__ __forceinline__ int lds_byte(int r, int c) { const int st = (r >> 4) * 2 + (c >> 5), rr = r & 15, cc = c & 31, ob = rr * 64 + cc * 2; return st * 1024 + (ob ^ (((ob >> 9) & 1) << 5)); }
__host__ __device__ __forceinline__ void stage_rc(int b, int& R, int& C) { const int st = b / 1024, sb = b % 1024, swz = sb ^ (((sb >> 9) & 1) << 5); R = (st >> 1) * 16 + swz / 64; C = (st & 1) * 32 + (swz % 64) / 2; }
__host__ __device__ __forceinline__ int perm32(int rho) { const int n = rho >> 4, i = rho & 15; return 8 * (i >> 2) + 4 * n + (i & 3); }

struct Unit { int pm, pn, seg; };
struct Gemm { const bf16_t* A; const bf16_t* Bt; int ld; int kseg; };

struct Order {
    int nM, nN, nwg, G, c, segshift, rev;
    __device__ void init(int M, int N, int G_, int c_, int segshift_, int rev_ = 0) { nM = M / BM; nN = N / BM; nwg = nM * nN; G = G_; c = c_; segshift = segshift_; rev = rev_; }
    __device__ bool next(int i, Unit& u) const {
        const long L = (long)(i >> segshift) * G + c; if (L >= nwg) return false;
        int wgid = (int)L; { const int q = nwg / NXCD, r = nwg % NXCD, xcd = wgid % NXCD, off = wgid / NXCD; wgid = (xcd < r ? xcd * (q + 1) : r * (q + 1) + (xcd - r) * q) + off; }
        const int nig = WGM * nN, gid = wgid / nig, fm = gid * WGM, gsz = (nM - fm) < WGM ? (nM - fm) : WGM;
        u.pm = fm + ((wgid % nig) % gsz); u.pn = (wgid % nig) / gsz; if (rev) u.pn = nN - 1 - u.pn; u.seg = i & ((1 << segshift) - 1); return true;
    }
};


__host__ __device__ __forceinline__ int g1_row(int n) {
    const bool rope = (n < 768) || (n >= 1536 && n < 2560);
    if (!rope) return n;
    const int hb = n & ~127, d = n & 127, dd = d & 63;
    return hb + 8 * (dd >> 2) + (dd & 3) + ((d >> 6) << 2);
}
__host__ __device__ __forceinline__ int gm_row(int c) { const int n = c >> 11, d = c & 2047; return 256 * (d >> 6) + 128 * (n >> 1) + 32 * ((d >> 4) & 3) + 8 * ((d >> 2) & 3) + 4 * (n & 1) + (d & 3); }
struct EpiG1 {
    static constexpr bool PERM = true; static constexpr int PF = 0; static constexpr bool MID = false;
    __device__ __forceinline__ void pf(const Unit&, int, LAS unsigned char*, int, int) const {}
    bf16_t* qkvg; bf16_t* mg;
    __device__ __forceinline__ bool zero_after(const Unit&) const { return true; }
    __device__ __forceinline__ void operator()(f32x4 (&acc)[2][2][4][2], const Unit& u, int wr, int wc, int fr, int fq) const {
        const int row0 = u.pm * BM + wr * 64 + fr; const int pn = u.pn;
        if (pn <= 2 || (pn >= 6 && pn <= 9)) {
            const int g4 = (4 * wc + fq) * 4;
            const f32x4 inv = *(const f32x4*)(INV64 + g4);
#pragma unroll
            for (int ai = 0; ai < 2; ++ai)
#pragma unroll
                for (int m = 0; m < 4; ++m) { const int row = row0 + ai * HALF + m * 16; const float pos = (float)(row & (SEQ - 1));
                    bf16_t* rowp = qkvg + (size_t)row * INC + pn * BM + g4;
                    f32x4 cs, sn;
#pragma unroll
                    for (int e = 0; e < 4; ++e) { const float ang = pos * inv[e]; double rev = (double)ang * 0.15915494309189535; rev -= __builtin_rint(rev);
                        const float fr_ = (float)rev; sn[e] = __builtin_amdgcn_sinf(fr_); cs[e] = __builtin_amdgcn_cosf(fr_); }
#pragma unroll
                    for (int bj = 0; bj < 2; ++bj) { const f32x4 a = acc[ai][bj][m][0], b = acc[ai][bj][m][1];
                        const f32x4 oa = a * cs - b * sn, ob = b * cs + a * sn;
                        u32x2 wa, wb; wa.x = cvt_pk_bf16(oa[0], oa[1]); wa.y = cvt_pk_bf16(oa[2], oa[3]); wb.x = cvt_pk_bf16(ob[0], ob[1]); wb.y = cvt_pk_bf16(ob[2], ob[3]);
                        const auto s0 = __builtin_amdgcn_permlane16_swap(wa.x, wb.x, false, false), s1 = __builtin_amdgcn_permlane16_swap(wa.y, wb.y, false, false);
                        const u32x4 o16 = {s0[0], s1[0], s0[1], s1[1]};
                        *(u32x4*)(rowp + bj * HALF + ((fq & 1) ? 60 : 0)) = o16; } }
            return;
        }
        if (pn >= 28) {
            const int d0 = 64 * (pn - 28) + 16 * wc + 4 * fq;
#pragma unroll
            for (int ai = 0; ai < 2; ++ai)
#pragma unroll
                for (int m = 0; m < 4; ++m) { const int row = row0 + ai * HALF + m * 16;
                    f32x4 ex[4], gg[4];
#pragma unroll
                    for (int n = 0; n < 4; ++n)
#pragma unroll
                        for (int e = 0; e < 4; ++e) { ex[n][e] = __expf(-acc[ai][n >> 1][m][n & 1][e]); gg[n][e] = __builtin_amdgcn_rcpf(1.0f + ex[n][e]); }
                    u32x2 w[4];
#pragma unroll
                    for (int n = 0; n < 4; ++n) { f32x4 r = gg[n]; if (n < 3) r = r * (ex[n + 1] + 1.0f);
                        w[n].x = cvt_pk_bf16(r[0], r[1]); w[n].y = cvt_pk_bf16(r[2], r[3]); }
                    const auto s0 = __builtin_amdgcn_permlane16_swap(w[0].x, w[2].x, false, false), s1 = __builtin_amdgcn_permlane16_swap(w[0].y, w[2].y, false, false);
                    const auto t0 = __builtin_amdgcn_permlane16_swap(w[1].x, w[3].x, false, false), t1 = __builtin_amdgcn_permlane16_swap(w[1].y, w[3].y, false, false);
                    const u32x4 oA = {s0[0], s1[0], s0[1], s1[1]}, oB = {t0[0], t1[0], t0[1], t1[1]};
                    bf16_t* dst = mg + (size_t)((fq & 1) * 2) * NTOK * DM + (size_t)row * DM + (d0 & ~7);
                    *(u32x4*)dst = oA; *(u32x4*)(dst + (size_t)NTOK * DM) = oB; }
            return;
        }
        int mode, ldc, colt; bf16_t* base;
        if (pn < 28) { base = qkvg; ldc = INC; colt = pn * BM; mode = (pn == 4 || pn == 5 || pn == 12 || pn == 13 || pn == 18 || pn == 19 || pn == 26 || pn == 27) ? 1 : 0; }
        else { base = mg + (size_t)((pn - 28) >> 3) * NTOK * DM; ldc = DM; colt = ((pn - 28) & 7) * BM; mode = 2; }
        const int col0 = colt + wc * 32 + 8 * fq;
#pragma unroll
        for (int ai = 0; ai < 2; ++ai)
#pragma unroll
            for (int m = 0; m < 4; ++m) { bf16_t* rowp = base + (size_t)(row0 + ai * HALF + m * 16) * ldc + col0;
#pragma unroll
                for (int bj = 0; bj < 2; ++bj) { f32x4 v0 = acc[ai][bj][m][0], v1 = acc[ai][bj][m][1];
                    if (mode != 0) {
#pragma unroll
                        for (int e = 0; e < 4; ++e) { const float s0 = sigmoidf_(v0[e]), s1 = sigmoidf_(v1[e]); v0[e] = (mode == 1) ? v0[e] * s0 : s0; v1[e] = (mode == 1) ? v1[e] * s1 : s1; }
                    }
                    u32x4 w; w.x = cvt_pk_bf16(v0[0], v0[1]); w.y = cvt_pk_bf16(v0[2], v0[3]); w.z = cvt_pk_bf16(v1[0], v1[1]); w.w = cvt_pk_bf16(v1[2], v1[3]);
                    *(u32x4*)(rowp + bj * HALF) = w; } }
    }
};
struct EpiG2 {
    static constexpr bool PERM = true; static constexpr int PF = 0; static constexpr bool MID = true;
    const bf16_t* mg; bf16_t* out;
    __device__ __forceinline__ void pf(const Unit& u, int step, LAS unsigned char* slot, int wid, int lane) const {
        const int s = step >> 4, row = u.pm * BM + 16 * (step & 15) + 2 * wid + (lane >> 5), g1 = s < 3 ? s + 1 : 3;
        const char* b0 = (const char*)mg + ((size_t)row * GMC + u.pn * BM) * 2 + (lane & 31) * 16;
        __builtin_amdgcn_global_load_lds((const unsigned*)(b0 + (size_t)s * DM * 2), (LAS unsigned*)slot, 16, 0, 0);
        __builtin_amdgcn_global_load_lds((const unsigned*)(b0 + (size_t)g1 * DM * 2), (LAS unsigned*)slot, 16, 0, 0);
    }
    __device__ __forceinline__ bool zero_after(const Unit&) const { return true; }
    template <bool LAST>
    __device__ __forceinline__ void scale(f32x4 (&acc)[2][2][4][2], const Unit& u, int seg, int wr, int wc, int fr, int fq) const {
        const int row0 = u.pm * BM + wr * 64 + fr, col0 = u.pn * BM + wc * 32 + 8 * fq;
        const unsigned goff0 = (unsigned)(seg * (NTOK * DM) + row0 * DM + col0) * 2u;
#pragma unroll
        for (int ai = 0; ai < 2; ++ai)
#pragma unroll
            for (int m = 0; m < 4; ++m) { const int row = row0 + ai * HALF + m * 16; const bf16_t* gp = (const bf16_t*)((const char*)mg + (goff0 + (unsigned)((ai * HALF + m * 16) * DM) * 2u));
#pragma unroll
                for (int bj = 0; bj < 2; ++bj) {
                    const u32x4 ga = *(const u32x4*)(gp + bj * HALF);
                    const float f[8] = {bf_lo(ga.x), bf_hi(ga.x), bf_lo(ga.y), bf_hi(ga.y), bf_lo(ga.z), bf_hi(ga.z), bf_lo(ga.w), bf_hi(ga.w)};
                    f32x4 v0 = acc[ai][bj][m][0], v1 = acc[ai][bj][m][1];
                    v0[0] *= f[0]; v0[1] *= f[1]; v0[2] *= f[2]; v0[3] *= f[3]; v1[0] *= f[4]; v1[1] *= f[5]; v1[2] *= f[6]; v1[3] *= f[7];
                    acc[ai][bj][m][0] = v0; acc[ai][bj][m][1] = v1;
                    if (LAST) { u32x4 w; w.x = cvt_pk_bf16(v0[0], v0[1]); w.y = cvt_pk_bf16(v0[2], v0[3]); w.z = cvt_pk_bf16(v1[0], v1[1]); w.w = cvt_pk_bf16(v1[2], v1[3]);
                        *(u32x4*)(out + (size_t)row * DM + col0 + bj * HALF) = w; } }
                asm volatile("" ::: "memory"); }
    }
    __device__ __forceinline__ void mid(f32x4 (&acc)[2][2][4][2], const Unit& u, int seg, int wr, int wc, int fr, int fq) const { scale<false>(acc, u, seg, wr, wc, fr, fq); }
    __device__ __forceinline__ void operator()(f32x4 (&acc)[2][2][4][2], const Unit& u, int wr, int wc, int fr, int fq) const { scale<true>(acc, u, 3, wr, wc, fr, fq); }
};
struct EpiG3 {
    static constexpr bool PERM = true; static constexpr int PF = 0; static constexpr bool MID = false;
    __device__ __forceinline__ void pf(const Unit& u, int step, LAS unsigned char* slot, int wid, int lane) const {
        const char* a;
        if (xin32) { const int ss = step >= 32 ? step - 32 : 0; a = (const char*)xin32 + ((size_t)(u.pm * BM + 8 * ss + wid) * DM + u.pn * BM) * 4 + lane * 16; }
        else { const int ss = step >= 48 ? step - 48 : 0; a = (const char*)xb + ((size_t)(u.pm * BM + 16 * ss + 2 * wid + (lane >> 5)) * DM + u.pn * BM) * 2 + (lane & 31) * 16; }
        __builtin_amdgcn_global_load_lds((const unsigned*)a, (LAS unsigned*)slot, 16, 0, 0);
    }
    const float* xin32; bf16_t* xb; const float* gate;
    __device__ __forceinline__ bool zero_after(const Unit&) const { return true; }
    __device__ __forceinline__ void operator()(f32x4 (&acc)[2][2][4][2], const Unit& u, int wr, int wc, int fr, int fq) const {
        const int col0 = u.pn * BM + wc * 32 + 8 * fq;
        const float* gp = gate + (size_t)((u.pm * BM) >> 13) * (3 * DM) + col0;
        f32x4 gv[2][2];
#pragma unroll
        for (int bj = 0; bj < 2; ++bj)
#pragma unroll
            for (int n = 0; n < 2; ++n) gv[bj][n] = *(const f32x4*)(gp + bj * HALF + n * 4);
#pragma unroll
        for (int ai = 0; ai < 2; ++ai)
#pragma unroll
            for (int m = 0; m < 4; ++m) { const size_t off = (size_t)(u.pm * BM + ai * HALF + wr * 64 + m * 16 + fr) * DM + col0;
#pragma unroll
                for (int bj = 0; bj < 2; ++bj) { f32x4 x0, x1;
                    if (xin32) { x0 = *(const f32x4*)(xin32 + off + bj * HALF); x1 = *(const f32x4*)(xin32 + off + bj * HALF + 4); }
                    else { const u32x4 r = *(const u32x4*)(xb + off + bj * HALF); x0 = (f32x4){bf_lo(r.x), bf_hi(r.x), bf_lo(r.y), bf_hi(r.y)}; x1 = (f32x4){bf_lo(r.z), bf_hi(r.z), bf_lo(r.w), bf_hi(r.w)}; }
                    const f32x4 y0 = x0 + gv[bj][0] * acc[ai][bj][m][0], y1 = x1 + gv[bj][1] * acc[ai][bj][m][1];
                    u32x4 w; w.x = cvt_pk_bf16(y0[0], y0[1]); w.y = cvt_pk_bf16(y0[2], y0[3]); w.z = cvt_pk_bf16(y1[0], y1[1]); w.w = cvt_pk_bf16(y1[2], y1[3]);
                    *(u32x4*)(xb + off + bj * HALF) = w; }
                if (m & 1) asm volatile("" ::: "memory"); }
    }
};

template <class Epi, bool ALIGN = true>
__device__ __forceinline__ void gemm_phase(LAS unsigned char* lds, const Gemm g, const Order& S, const Epi& E) {
    int tid = threadIdx.x; asm volatile("" : "+v"(tid));
    const int wid = __builtin_amdgcn_readfirstlane(tid >> 6), lane = tid & 63, wr = wid >> 2, wc = wid & 3, fr = lane & 15, fq = lane >> 4;
    const int K = g.ld, nt = g.kseg / BK;
    unsigned voffA[2], voffB[2];
#pragma unroll
    for (int i = 0; i < 2; ++i) { int R, C; stage_rc(tid * 16 + i * 8192, R, C); const int Rb = Epi::PERM ? ((R & ~31) + perm32(R & 31)) : R;
        voffA[i] = (unsigned)(R * K + C) * 2u; voffB[i] = (unsigned)(Rb * K + C) * 2u; }
    const size_t kstep = (size_t)(BK * 2);
    const size_t hstep = (size_t)HALF * K * 2;
    const size_t tstep = 2 * hstep;
    const size_t sstep = (size_t)g.kseg * 2;
    const unsigned ldsw = (unsigned)wid * 1024u;
    const int aoff = lds_byte(wr * 64 + fr, fq * 8), boff = lds_byte(wc * 32 + fr, fq * 8);
    LAS unsigned char* pfslot = lds + STAGE_BYTES + ldsw;
#define PG8_SA(b, h) (((b) * 2 + (h)) * HTB)
#define PG8_SB(b, h) ((4 + (b) * 2 + (h)) * HTB)
#define PG8_STAGE(bufoff, gbase, voff) do { _Pragma("unroll") for (int _i = 0; _i < 2; ++_i) \
        __builtin_amdgcn_global_load_lds((const unsigned*)((const char*)(gbase) + (voff)[_i]), (LAS unsigned*)(lds + (bufoff) + ldsw + _i * 8192), 16, 0, 0); } while (0)
#define PG8_LDA(dst, b, h) do { _Pragma("unroll") for (int m = 0; m < 4; ++m) _Pragma("unroll") for (int k = 0; k < 2; ++k) dst[m][k] = *(const LAS bf16x8*)(lds + PG8_SA(b, h) + aoff + m * 2048 + k * 1024); } while (0)
#define PG8_LDB(dst, b, h) do { _Pragma("unroll") for (int n = 0; n < 2; ++n) _Pragma("unroll") for (int k = 0; k < 2; ++k) dst[n][k] = *(const LAS bf16x8*)(lds + PG8_SB(b, h) + boff + n * 2048 + k * 1024); } while (0)
#define PG8_MMA(ai, bj, At, Bt) do { __builtin_amdgcn_s_setprio(1); _Pragma("unroll") for (int m = 0; m < 4; ++m) _Pragma("unroll") for (int n = 0; n < 2; ++n) _Pragma("unroll") for (int k = 0; k < 2; ++k) \
        acc[ai][bj][m][n] = __builtin_amdgcn_mfma_f32_16x16x32_bf16(Bt[n][k], At[m][k], acc[ai][bj][m][n], 0, 0, 0); __builtin_amdgcn_s_setprio(0); } while (0)
#define PG8_WAIT_V(n) asm volatile("s_waitcnt vmcnt(" #n ")" ::: "memory")
#define PG8_WAIT_VL() asm volatile("s_waitcnt vmcnt(%0)" :: "n"(8 + 3 * Epi::PF) : "memory")
#define PG8_PF(j) do { if constexpr (Epi::PF > 0) E.pf(cur, 2 * t + (j), pfslot, wid, lane); } while (0)
#define PG8_WAIT_L(n) asm volatile("s_waitcnt lgkmcnt(" #n ")" ::: "memory")
#define PG8_BAR __builtin_amdgcn_s_barrier()
#define PG8_SCHED __builtin_amdgcn_sched_barrier(0)
#define PG8_UA(u) ((const char*)g.A + (size_t)(u).pm * tstep + (size_t)(u).seg * sstep)
#define PG8_UB(u) ((const char*)g.Bt + (size_t)(u).pn * tstep + (size_t)(u).seg * sstep)
    Unit cur, nxt; int ui = 0;
    if (!S.next(0, cur)) return;
    f32x4 acc[2][2][4][2];
#pragma unroll
    for (int a = 0; a < 2; ++a)
#pragma unroll
        for (int b = 0; b < 2; ++b)
#pragma unroll
            for (int m = 0; m < 4; ++m)
#pragma unroll
                for (int n = 0; n < 2; ++n) acc[a][b][m][n] = (f32x4){0.f, 0.f, 0.f, 0.f};
    bf16x8 At[4][2], B0[2][2], B1[2][2];
    const char* cA = PG8_UA(cur); const char* cB = PG8_UB(cur);
    PG8_STAGE(PG8_SB(0, 0), cB, voffB); PG8_STAGE(PG8_SB(0, 1), cB + hstep, voffB); PG8_STAGE(PG8_SA(0, 0), cA, voffA); PG8_STAGE(PG8_SA(0, 1), cA + hstep, voffA);
    if (wr == 1) PG8_BAR;
    PG8_WAIT_V(2); PG8_BAR;
    PG8_STAGE(PG8_SB(1, 0), cB + kstep, voffB); PG8_STAGE(PG8_SA(1, 0), cA + kstep, voffA); PG8_STAGE(PG8_SB(1, 1), cB + hstep + kstep, voffB);
    PG8_WAIT_V(6); PG8_BAR;
    for (;;) {
        const bool has_next = S.next(ui + 1, nxt);
        const char* nA = has_next ? PG8_UA(nxt) : cA; const char* nB = has_next ? PG8_UB(nxt) : cB;
        for (int t = 0; t < nt; t += 2) {
            const bool last = (t == nt - 2);
            const char* a1 = cA + (size_t)(t + 1) * kstep;
            const char* a2 = last ? nA : cA + (size_t)(t + 2) * kstep; const char* b2 = last ? nB : cB + (size_t)(t + 2) * kstep;
            const char* a3 = a2 + kstep; const char* b3 = b2 + kstep;
            PG8_LDB(B0, 0, 0); PG8_LDB(B1, 0, 1); PG8_SCHED; PG8_LDA(At, 0, 0); PG8_STAGE(PG8_SA(1, 1), a1 + hstep, voffA); PG8_PF(0);
            PG8_WAIT_VL(); PG8_WAIT_L(0); PG8_BAR; PG8_MMA(0, 0, At, B0); PG8_MMA(0, 1, At, B1); PG8_BAR; PG8_SCHED;
            PG8_LDA(At, 0, 1); PG8_STAGE(PG8_SB(0, 0), b2, voffB); PG8_STAGE(PG8_SB(0, 1), b2 + hstep, voffB); PG8_STAGE(PG8_SA(0, 0), a2, voffA); PG8_PF(1);
            PG8_WAIT_VL(); PG8_WAIT_L(0); PG8_BAR; PG8_MMA(1, 0, At, B0); PG8_MMA(1, 1, At, B1); PG8_BAR; PG8_SCHED;
            PG8_LDB(B0, 1, 0); PG8_LDB(B1, 1, 1); PG8_SCHED; PG8_LDA(At, 1, 0); PG8_STAGE(PG8_SA(0, 1), a2 + hstep, voffA); PG8_PF(2);
            PG8_WAIT_VL(); PG8_WAIT_L(0); PG8_BAR; PG8_MMA(0, 0, At, B0); PG8_MMA(0, 1, At, B1); PG8_BAR; PG8_SCHED;
            PG8_LDA(At, 1, 1); PG8_STAGE(PG8_SB(1, 0), b3, voffB); PG8_STAGE(PG8_SB(1, 1), b3 + hstep, voffB); PG8_STAGE(PG8_SA(1, 0), a3, voffA); PG8_PF(3);
            PG8_WAIT_VL(); PG8_WAIT_L(0); PG8_BAR; PG8_MMA(1, 0, At, B0); PG8_MMA(1, 1, At, B1); PG8_BAR; PG8_SCHED;
            if constexpr (Epi::MID) { if (((t + 2) & 7) == 0 && !last) { E.mid(acc, cur, ((t + 2) >> 3) - 1, wr, wc, fr, fq); PG8_SCHED; } }
        }
        if constexpr (ALIGN) { if (wr == 0) PG8_BAR; }
        E(acc, cur, wr, wc, fr, fq);
        if (!has_next) break;
        if (E.zero_after(cur)) {
#pragma unroll
            for (int a = 0; a < 2; ++a)
#pragma unroll
                for (int b = 0; b < 2; ++b)
#pragma unroll
                    for (int m = 0; m < 4; ++m)
#pragma unroll
                        for (int n = 0; n < 2; ++n) acc[a][b][m][n] = (f32x4){0.f, 0.f, 0.f, 0.f};
        }
        cur = nxt; cA = nA; cB = nB; ++ui;
        if constexpr (ALIGN) { if (wr == 1) PG8_BAR; }
    }
    PG8_WAIT_V(0);
    if constexpr (!ALIGN) { if (wr == 0) PG8_BAR; }
    PG8_BAR;
#undef PG8_SA
#undef PG8_SB
#undef PG8_STAGE
#undef PG8_LDA
#undef PG8_LDB
#undef PG8_MMA
#undef PG8_WAIT_V
#undef PG8_WAIT_VL
#undef PG8_PF
#undef PG8_WAIT_L
#undef PG8_BAR
#undef PG8_SCHED
#undef PG8_UA
#undef PG8_UB
}
}

namespace att {
constexpr int D = 128, NW = 8, QBLK = 32, KVBLK = 64;
constexpr float SCALE = 0.088388347648318440f;
constexpr float THR = 8.f;
constexpr int SDEPTH = 2;
constexpr size_t SHM_V = KVBLK * D * 2, SHM_K = KVBLK * D * 2, SHM_ATTN = 2 * SHM_V + 2 * SHM_K + NW * 64 * 4;
constexpr float NEGBIG = -1e30f, MFLOOR = -30000.f;
#define KSWZ(row, colB) ((row) * 256 + ((colB) ^ (((row) & 7) << 4)))
#define SBAR() __builtin_amdgcn_sched_barrier(0)
__device__ __forceinline__ int sr_f(int tid) { return tid >> 4; }
__device__ __forceinline__ int crow(int r, int hi) { return (r & 3) + 8 * (r >> 2) + 4 * hi; }
__device__ __forceinline__ unsigned cvtpk(float lo, float hi) { return cvt_pk_bf16(lo, hi); }

__device__ __forceinline__ void partialSM(f32x16& p0, f32x16& p1, float& m_reg, float& mn, float& alpha) {
  constexpr float C = SCALE * 1.4426950408889634f;
  float pmax = p0[0]; for (int r = 1; r < 16; ++r) pmax = fmaxf(pmax, p0[r]); for (int r = 0; r < 16; ++r) pmax = fmaxf(pmax, p1[r]);
  { auto rr = __builtin_amdgcn_permlane32_swap(__float_as_uint(pmax), __float_as_uint(pmax), false, false);
    pmax = fmaxf(__uint_as_float(rr[0]), __uint_as_float(rr[1])); }
  if (__builtin_expect(__all(pmax - m_reg <= THR / SCALE), 1)) { mn = m_reg; alpha = 1.f; }
  else { mn = fmaxf(m_reg, pmax); alpha = __builtin_amdgcn_exp2f((m_reg - mn) * C); m_reg = mn; }
  float mnC = -mn * C;
  for (int r = 0; r < 16; ++r) p0[r] = fmaf(p0[r], C, mnC); for (int r = 0; r < 16; ++r) p1[r] = fmaf(p1[r], C, mnC);
  for (int r = 0; r < 16; ++r) p0[r] = __builtin_amdgcn_exp2f(p0[r]);
}
__device__ __forceinline__ void finishSM(f32x16& p0, f32x16& p1, float alpha, float& l_reg, bf16x8& pa0, bf16x8& pa1, bf16x8& pa2, bf16x8& pa3) {
  for (int r = 0; r < 16; ++r) p1[r] = __builtin_amdgcn_exp2f(p1[r]);
  float ps = 0; for (int r = 0; r < 16; ++r) ps += p0[r]; for (int r = 0; r < 16; ++r) ps += p1[r];
  { auto rr = __builtin_amdgcn_permlane32_swap(__float_as_uint(ps), __float_as_uint(ps), false, false);
    ps = __uint_as_float(rr[0]) + __uint_as_float(rr[1]); }
  l_reg = l_reg * alpha + ps;
#define PK4(P, BASE, OUT) do { unsigned a0 = cvtpk(P[BASE + 0], P[BASE + 1]), a1 = cvtpk(P[BASE + 2], P[BASE + 3]);   \
    unsigned b0 = cvtpk(P[BASE + 4], P[BASE + 5]), b1 = cvtpk(P[BASE + 6], P[BASE + 7]);                              \
    auto r0 = __builtin_amdgcn_permlane32_swap(a0, b0, false, false); auto r1 = __builtin_amdgcn_permlane32_swap(a1, b1, false, false); \
    u32x4 w = {r0[0], r1[0], r0[1], r1[1]}; OUT = *reinterpret_cast<bf16x8*>(&w); } while (0)
  PK4(p0, 0, pa0); PK4(p0, 8, pa1); PK4(p1, 0, pa2); PK4(p1, 8, pa3);
#undef PK4
}
__device__ __forceinline__ void qkt(f32x16& p0, f32x16& p1, const LAS char* Ks, const bf16x8* qr, int r32, int hi) {
  p0 = f32x16{}; p1 = f32x16{};
  for (int d0 = 0; d0 < 8; ++d0) { int cb = (d0 * 16 + hi * 8) * 2;
    bf16x8 b0 = *reinterpret_cast<const LAS bf16x8*>(Ks + KSWZ(r32, cb));
    bf16x8 b1 = *reinterpret_cast<const LAS bf16x8*>(Ks + KSWZ(32 + r32, cb));
    p0 = __builtin_amdgcn_mfma_f32_32x32x16_bf16(b0, qr[d0], p0, 0, 0, 0);
    p1 = __builtin_amdgcn_mfma_f32_32x32x16_bf16(b1, qr[d0], p1, 0, 0, 0); }
}
__device__ __forceinline__ int v_st(int k, int c) { const int kk = (k & ~0xC) | ((k & 4) << 1) | ((k & 8) >> 1); return ((kk >> 3) * 4 + (c >> 5)) * 512 + ((kk & 7) * 32 + (c & 31)) * 2; }
__device__ __forceinline__ int v_rd_base(int lane) { return ((lane & 3) << 3) | (((lane >> 2) & 3) << 6) | (((lane >> 4) & 1) << 5) | (((lane >> 5) & 1) << 8); }
constexpr int v_rd_off(int d0, int ks, int half) { return d0 * 512 + ks * 4096 + half * 2048; }
template <int OFF> __device__ __forceinline__ s16x4 tr_read(int vb) {
  s16x4 r; asm volatile("ds_read_b64_tr_b16 %0, %1 offset:%2" : "=&v"(r) : "v"(vb), "i"(OFF) : "memory"); return r;
}
template <int D0> __device__ __forceinline__ void pv_one(f32x16& od, int vb, bf16x8 pa0, bf16x8 pa1, bf16x8 pa2, bf16x8 pa3) {
  const s16x4 l0 = tr_read<v_rd_off(D0, 0, 0)>(vb), h0 = tr_read<v_rd_off(D0, 0, 1)>(vb), l1 = tr_read<v_rd_off(D0, 1, 0)>(vb), h1 = tr_read<v_rd_off(D0, 1, 1)>(vb);
  const s16x4 l2 = tr_read<v_rd_off(D0, 2, 0)>(vb), h2 = tr_read<v_rd_off(D0, 2, 1)>(vb), l3 = tr_read<v_rd_off(D0, 3, 0)>(vb), h3 = tr_read<v_rd_off(D0, 3, 1)>(vb);
  asm volatile("s_waitcnt lgkmcnt(0)" ::: "memory"); SBAR();
#define PK(L, H) (bf16x8){L[0], L[1], L[2], L[3], H[0], H[1], H[2], H[3]}
  od = __builtin_amdgcn_mfma_f32_32x32x16_bf16(pa0, PK(l0, h0), od, 0, 0, 0);
  od = __builtin_amdgcn_mfma_f32_32x32x16_bf16(pa1, PK(l1, h1), od, 0, 0, 0);
  od = __builtin_amdgcn_mfma_f32_32x32x16_bf16(pa2, PK(l2, h2), od, 0, 0, 0);
  od = __builtin_amdgcn_mfma_f32_32x32x16_bf16(pa3, PK(l3, h3), od, 0, 0, 0);
#undef PK
}
__device__ __forceinline__ void pv_d0(f32x16* o, int vb, bf16x8 pa0, bf16x8 pa1, bf16x8 pa2, bf16x8 pa3) {
  pv_one<0>(o[0], vb, pa0, pa1, pa2, pa3); pv_one<1>(o[1], vb, pa0, pa1, pa2, pa3); pv_one<2>(o[2], vb, pa0, pa1, pa2, pa3); pv_one<3>(o[3], vb, pa0, pa1, pa2, pa3);
}

struct MaskNone { static constexpr bool ANY = false; __device__ __forceinline__ void apply(f32x16&, f32x16&, int, int, int, int) const {} };
struct MaskBand {
  static constexpr bool ANY = true; int d0, reach;
  __device__ __forceinline__ void apply(f32x16& p0, f32x16& p1, int tile, int wid, int r32, int hi) const {
    const int base = d0 + tile * 64 - (wid * 32 + r32) + 4 * hi + reach; const unsigned lim = 2u * (unsigned)reach;
#pragma unroll
    for (int r = 0; r < 16; ++r) { const int k = (r & 3) + 8 * (r >> 2);
      if ((unsigned)(base + k) > lim) p0[r] = NEGBIG;
      if ((unsigned)(base + k + 32) > lim) p1[r] = NEGBIG; }
  }
};
struct MaskBand2 {
  static constexpr bool ANY = true; int d0;
  __device__ __forceinline__ void apply(f32x16& p0, f32x16& p1, int tile, int wid, int r32, int hi) const {
    constexpr float LN2R = 0.6931471805599453f / SCALE;
    const int base = d0 + tile * 64 - (wid * 32 + r32) + 4 * hi; const int al = (-base) & 3;
#pragma unroll
    for (int r = 0; r < 16; ++r) { const int k = (r & 3) + 8 * (r >> 2); const bool aligned = ((r & 3) == al);
      { const int d = base + k; const bool v1 = (unsigned)(d + 64) <= 128u, v2 = aligned && ((unsigned)(d + 256) <= 512u);
        p0[r] = v1 ? (v2 ? p0[r] + LN2R : p0[r]) : (v2 ? p0[r] : NEGBIG); }
      { const int d = base + k + 32; const bool v1 = (unsigned)(d + 64) <= 128u, v2 = aligned && ((unsigned)(d + 256) <= 512u);
        p1[r] = v1 ? (v2 ? p1[r] + LN2R : p1[r]) : (v2 ? p1[r] : NEGBIG); } }
  }
};
struct MaskNA {
  static constexpr bool ANY = true; int qrow0, krow0; const LAS float* tab;
  __device__ __forceinline__ void apply(f32x16& p0, f32x16& p1, int tile, int wid, int r32, int hi) const {
    const int qr = qrow0 + (wid >> 1), kr = krow0 + tile; int rs = qr - 4; rs = rs < 0 ? 0 : (rs > 120 ? 120 : rs);
    if (kr < rs || kr >= rs + 8) {
#pragma unroll
      for (int r = 0; r < 16; ++r) { p0[r] = NEGBIG; p1[r] = NEGBIG; }
    } else {
      const int qc = (wid & 1) * 32 + r32; int cs = qc - 8; cs = cs < 0 ? 0 : (cs > 48 ? 48 : cs);
      const LAS float* trow = tab + (kr - qr + 7) * 128 + 63 - qc + 4 * hi;
      const int cb = 4 * hi - cs;
#pragma unroll
      for (int r = 0; r < 16; ++r) { const int k = (r & 3) + 8 * (r >> 2);
        p0[r] = ((unsigned)(cb + k) < 16u) ? p0[r] + trow[k] : NEGBIG;
        p1[r] = ((unsigned)(cb + k + 32) < 16u) ? p1[r] + trow[k + 32] : NEGBIG;
        if ((r & 3) == 3) asm volatile("" ::: "memory"); }
    }
  }
};
struct OutGated {
  bf16_t* y; const bf16_t* gate;
  __device__ __forceinline__ void store8(int row, int col, f32x4 v0, f32x4 v1) const {
    const u32x4 g = *(const u32x4*)((const char*)gate + (unsigned)(row * INC + col) * 2u);
    u32x4 w; w.x = cvt_pk_bf16(v0.x * bf_lo(g.x), v0.y * bf_hi(g.x)); w.y = cvt_pk_bf16(v0.z * bf_lo(g.y), v0.w * bf_hi(g.y));
    w.z = cvt_pk_bf16(v1.x * bf_lo(g.z), v1.y * bf_hi(g.z)); w.w = cvt_pk_bf16(v1.z * bf_lo(g.w), v1.w * bf_hi(g.w));
    *(u32x4*)((char*)y + (unsigned)(row * DM + col) * 2u) = w; }
  __device__ __forceinline__ void lse(int, float, float) const {}
};
struct OutPartial {
  bf16_t* po; float* plse; int dil;
  __device__ __forceinline__ void store8(int row, int col, f32x4 v0, f32x4 v1) const {
    u32x4 w; w.x = cvt_pk_bf16(v0.x, v0.y); w.y = cvt_pk_bf16(v0.z, v0.w); w.z = cvt_pk_bf16(v1.x, v1.y); w.w = cvt_pk_bf16(v1.z, v1.w);
    *(u32x4*)((char*)po + (unsigned)(row * dil * 512 + col) * 2u) = w; }
  __device__ __forceinline__ void lse(int row, float m, float l) const { plse[(unsigned)(row * dil * 4)] = m * SCALE + __logf(l); }
};
constexpr int TAB_OFF = 67584, STG_OFF = 75776, STG_STRIDE = 68, STG_WAVE = 32 * STG_STRIDE * 4;

template <class Mask, class Out, int SD = 2, bool PACK2 = false, bool ODD = false>
__device__ __forceinline__ void attn_unit(const bf16_t* __restrict__ Qb, const bf16_t* __restrict__ Kh, const bf16_t* __restrict__ Vh, const int ldq, const int ldk,
                                          const int NT, const float m_init, const float l_init, const Mask& mask, const Out& out, LAS char* lds, const float m_init1 = 0.f) {
  int tid = threadIdx.x; asm volatile("" : "+v"(tid));
  const int wid = __builtin_amdgcn_readfirstlane(tid >> 6), lane = tid & 63, r32 = lane & 31, hi = lane >> 5;
  const int wq = PACK2 ? (wid & 3) : wid, hsel = PACK2 ? (wid >> 2) : 0;
  LAS char* V_lds = lds; LAS char* K_lds = lds + 2 * SHM_V;
  LAS float* ws = (LAS float*)(lds + 2 * SHM_V + 2 * SHM_K) + wid * 64; LAS float* li_l = ws; LAS float* al_l = ws + 32;
  float m_reg = (PACK2 && hsel) ? m_init1 : m_init, l_reg = l_init; f32x16 o[4] = {}; bf16x8 qr[8];
  { const unsigned qoff = (unsigned)((wq * QBLK + r32) * ldq + hi * 8) * 2u + (unsigned)hsel * 256u;
#pragma unroll
    for (int d0 = 0; d0 < 8; ++d0) qr[d0] = *reinterpret_cast<const bf16x8*>((const char*)Qb + qoff + d0 * 32); }
  const unsigned kvoff = (unsigned)(sr_f(tid) * ldk + (tid & 15) * 8) * 2u; const size_t tileb = (size_t)ldk * 2, half32 = tileb * 32;
  const int sr = tid >> 4, sc = (tid & 15) * 8, vst0 = v_st(sr, sc), vst1 = v_st(32 + sr, sc);
  const int vb0 = (int)(uintptr_t)V_lds + v_rd_base(lane);
  struct { bf16x8 vs0, vs1, ks0, ks1; } sr_[SD];
#define SLOAD(i, k0) do { const char* vp_ = (const char*)Vh + (size_t)(k0) * tileb; const char* kp_ = (const char*)Kh + (size_t)(k0) * tileb; \
    sr_[i].vs0 = *reinterpret_cast<const bf16x8*>(vp_ + kvoff); sr_[i].vs1 = *reinterpret_cast<const bf16x8*>(vp_ + half32 + kvoff); \
    sr_[i].ks0 = *reinterpret_cast<const bf16x8*>(kp_ + kvoff); sr_[i].ks1 = *reinterpret_cast<const bf16x8*>(kp_ + half32 + kvoff); } while (0)
#define SWRITE(b, i) do { *(LAS bf16x8*)(V_lds + (b) * SHM_V + vst0) = sr_[i].vs0;          \
    *(LAS bf16x8*)(V_lds + (b) * SHM_V + vst1) = sr_[i].vs1; int kc = sc * 2;               \
    *(LAS bf16x8*)(K_lds + (b) * SHM_K + KSWZ(sr, kc)) = sr_[i].ks0;                       \
    *(LAS bf16x8*)(K_lds + (b) * SHM_K + KSWZ(32 + sr, kc)) = sr_[i].ks1; } while (0)
#define SWAIT() do { if constexpr (SD == 2) asm volatile("s_waitcnt vmcnt(4)" ::: "memory"); else asm volatile("s_waitcnt vmcnt(0)" ::: "memory"); } while (0)
#define RESC(a) do { if (__any((a) < 1.f)) { if (hi == 0) al_l[r32] = (a); asm volatile("s_waitcnt lgkmcnt(0)" ::: "memory"); \
    for (int d = 0; d < 4; ++d) for (int r = 0; r < 16; ++r) o[d][r] *= al_l[crow(r, hi)]; } } while (0)
  f32x16 pA0, pA1, pB0, pB1; float mnA, mnB, alA, alB; bf16x8 pa0, pa1, pa2, pa3;
  constexpr int SE = 0, SO = SD - 1;
  SLOAD(SE, 0); asm volatile("s_waitcnt vmcnt(0)" ::: "memory"); SWRITE(0, SE); __syncthreads();
  qkt(pA0, pA1, K_lds, qr, r32, hi); mask.apply(pA0, pA1, 0, wq, r32, hi); partialSM(pA0, pA1, m_reg, mnA, alA);
  SLOAD(SO, KVBLK); if constexpr (SD == 2) { if (2 < NT) SLOAD(SE, 2 * KVBLK); }
  SWAIT(); SWRITE(1, SO); __syncthreads();
  for (int j = 1; j + 1 < NT; j += 2) {
    SBAR(); qkt(pB0, pB1, K_lds + SHM_K, qr, r32, hi);
    finishSM(pA0, pA1, alA, l_reg, pa0, pa1, pa2, pa3); SBAR();
    if (!ODD || j + SD < NT) SLOAD(SO, (j + SD) * KVBLK); SBAR();
    pv_d0(o, vb0, pa0, pa1, pa2, pa3); mask.apply(pB0, pB1, j, wq, r32, hi); partialSM(pB0, pB1, m_reg, mnB, alB);
    __syncthreads(); SWAIT(); SWRITE(0, SE);
    RESC(alB); __syncthreads();
    SBAR(); qkt(pA0, pA1, K_lds, qr, r32, hi);
    finishSM(pB0, pB1, alB, l_reg, pa0, pa1, pa2, pa3); SBAR();
    if (SD == 1 || j + 3 < NT) SLOAD(SE, (j + 1 + SD) * KVBLK); SBAR();
    pv_d0(o, vb0 + (int)SHM_V, pa0, pa1, pa2, pa3); mask.apply(pA0, pA1, j + 1, wq, r32, hi); partialSM(pA0, pA1, m_reg, mnA, alA);
    __syncthreads(); SWAIT(); SWRITE(1, SO);
    RESC(alA); __syncthreads();
  }
  if constexpr (ODD) {
    finishSM(pA0, pA1, alA, l_reg, pa0, pa1, pa2, pa3); SBAR();
    pv_d0(o, vb0, pa0, pa1, pa2, pa3);
  } else {
  SBAR(); qkt(pB0, pB1, K_lds + SHM_K, qr, r32, hi);
  finishSM(pA0, pA1, alA, l_reg, pa0, pa1, pa2, pa3); SBAR();
  pv_d0(o, vb0, pa0, pa1, pa2, pa3); mask.apply(pB0, pB1, NT - 1, wq, r32, hi); partialSM(pB0, pB1, m_reg, mnB, alB);
  __syncthreads(); RESC(alB);
  finishSM(pB0, pB1, alB, l_reg, pa0, pa1, pa2, pa3); SBAR();
  pv_d0(o, vb0 + (int)SHM_V, pa0, pa1, pa2, pa3);
  }
  if (hi == 0) { li_l[r32] = l_reg; out.lse(wq * QBLK + r32, m_reg, l_reg); } asm volatile("s_waitcnt lgkmcnt(0)" ::: "memory");
  float rli[16];
#pragma unroll
  for (int r = 0; r < 16; ++r) rli[r] = __builtin_amdgcn_rcpf(li_l[crow(r, hi)]);
  LAS float* stg = (LAS float*)(lds + STG_OFF + wid * STG_WAVE);
#pragma unroll
  for (int half = 0; half < 2; ++half) {
#pragma unroll
    for (int r = 0; r < 16; ++r) {
      stg[crow(r, hi) * STG_STRIDE + r32] = o[half * 2][r] * rli[r]; stg[crow(r, hi) * STG_STRIDE + 32 + r32] = o[half * 2 + 1][r] * rli[r]; }
    asm volatile("s_waitcnt lgkmcnt(0)" ::: "memory");
#pragma unroll
    for (int i = 0; i < 4; ++i) { const int row = i * 8 + (lane >> 3), c8 = (lane & 7) * 8;
      const f32x4 v0 = *(const LAS f32x4*)(stg + row * STG_STRIDE + c8), v1 = *(const LAS f32x4*)(stg + row * STG_STRIDE + c8 + 4);
      out.store8(wq * QBLK + row, hsel * 128 + half * 64 + c8, v0, v1); }
    asm volatile("s_waitcnt lgkmcnt(0)" ::: "memory");
  }
#undef SLOAD
#undef SWRITE
#undef SWAIT
#undef RESC
}
}

#ifndef PH_A
#define PH_A 1
#endif
#ifndef PH_B
#define PH_B 1
#endif
#ifndef PH_C
#define PH_C 1
#endif
#ifndef PH_D
#define PH_D 1
#endif
#ifndef PH_G1
#define PH_G1 1
#endif
#ifndef PH_G2
#define PH_G2 1
#endif
#ifndef PH_G3
#define PH_G3 1
#endif

#ifndef PROBE
#define PROBE 0
#endif
#define REPS(k) ((PROBE == (k)) ? 2 : 1)
#define GSYNC() do { xcd_barrier(xbar); if (PROBE == 1) xcd_barrier(xbar); } while (0)

#ifndef TPROBE
#define TPROBE 0
#endif
#define TB(k) do { if (TPROBE == (k)) tp0 = __builtin_amdgcn_s_memrealtime(); } while (0)
#define TE(k) do { if (TPROBE == (k)) tpacc += __builtin_amdgcn_s_memrealtime() - tp0; } while (0)

#define XB_TMO      128
#define XB_XCNT(j)  (256  + 64 * (j))
#define XB_XSUB(j)  (1280 + 64 * (j))
#define XB_XGEN(j)  (2304 + 64 * (j))
#define XB_TOP      3328
#define XB_TOPGEN   3392
#define XCD_BAR_WORDS 3456
#define XB_SPIN_CAP (1u << 18)

__device__ __forceinline__ unsigned xb_ld(unsigned* p)              { return __hip_atomic_load(p, __ATOMIC_RELAXED, __HIP_MEMORY_SCOPE_AGENT); }
__device__ __forceinline__ unsigned xb_add(unsigned* p, unsigned v) { return __hip_atomic_fetch_add(p, v, __ATOMIC_RELAXED, __HIP_MEMORY_SCOPE_AGENT); }
__device__ __forceinline__ unsigned xb_xcc_id() { return (unsigned)__builtin_amdgcn_s_getreg((3 << 11) | 20) & 0xFu; }
#define XB_SPIN(cond, bar) do { unsigned _sp = 0; while (cond) { __builtin_amdgcn_s_sleep(1); \
    if ((++_sp & 255u) == 0u) { if (xb_ld(&(bar)[XB_TMO])) break; if (_sp > XB_SPIN_CAP) { atomicAdd(&(bar)[XB_TMO], 1u); break; } } } } while (0)

struct XcdBarrier {
    unsigned* bar; unsigned x;
    volatile LAS unsigned* st;
};

__device__ __forceinline__ XcdBarrier xcd_barrier_post(unsigned* bar, volatile LAS unsigned* st) {
    XcdBarrier b; b.bar = bar; b.x = xb_xcc_id(); b.st = st;
    if (threadIdx.x == 0) (void)xb_add(&bar[XB_XCNT(b.x)], 1u);
    return b;
}
__device__ __forceinline__ void xcd_barrier_complete(unsigned* bar, unsigned x, unsigned& nloc, unsigned& nx) {
    const unsigned G = gridDim.x * gridDim.y * gridDim.z;
    unsigned sum, cnt, mine, sp = 0u;
    for (;;) {
        sum = 0u; cnt = 0u; mine = 0u;
#pragma unroll
        for (unsigned j = 0; j < 16; ++j) { const unsigned c = xb_ld(&bar[XB_XCNT(j)]); sum += c; cnt += (c > 0u) ? 1u : 0u; mine = (j == x) ? c : mine; }
        if (sum == G) break;
        __builtin_amdgcn_s_sleep(1);
        if ((++sp & 255u) == 0u) { if (xb_ld(&bar[XB_TMO])) break; if (sp > XB_SPIN_CAP) { atomicAdd(&bar[XB_TMO], 1u); break; } }
    }
    nloc = mine > 0u ? mine : 1u; nx = cnt > 0u ? cnt : 1u;
}

__device__ __forceinline__ void xcd_barrier(const XcdBarrier& b) {
    asm volatile("s_waitcnt vmcnt(0)" ::: "memory");
    __syncthreads();
    if (threadIdx.x == 0) {
        unsigned* bar = b.bar;
        __builtin_amdgcn_s_waitcnt(0);
        unsigned nloc = b.st[0], nx = b.st[1];
        if (nloc == 0u) { xcd_barrier_complete(bar, b.x, nloc, nx); b.st[0] = nloc; b.st[1] = nx; }
        const unsigned old = xb_add(&bar[XB_XSUB(b.x)], 1u);
        const unsigned gen = old / nloc;
        if (old + 1u == (gen + 1u) * nloc) {
            __builtin_amdgcn_fence(__ATOMIC_RELEASE, "agent");
            asm volatile("s_waitcnt vmcnt(0)" ::: "memory");
            const unsigned og = xb_add(&bar[XB_TOP], 1u);
            const unsigned tg = og / nx;
            if (og + 1u == (tg + 1u) * nx) xb_add(&bar[XB_TOPGEN], 1u);
            else XB_SPIN(xb_ld(&bar[XB_TOPGEN]) == tg, bar);
            __builtin_amdgcn_fence(__ATOMIC_ACQUIRE, "agent");
            xb_add(&bar[XB_XGEN(b.x)], 1u);
            asm volatile("s_waitcnt vmcnt(0)" ::: "memory");
        } else {
            XB_SPIN(xb_ld(&bar[XB_XGEN(b.x)]) == gen, bar);
            __builtin_amdgcn_fence(__ATOMIC_ACQUIRE, "agent");
            asm volatile("s_waitcnt vmcnt(0)" ::: "memory");
        }
    }
    __syncthreads();
}

struct Params {
  const float *x, *c, *norm_g, *w_ada, *b_ada, *w_in, *a_sink, *c_q_norm, *c_k_norm, *d_rel_bias, *w_gm, *w_branch, *w_out, *final_g;
  float* out; unsigned char* ws;
};
constexpr int LDS_BYTES = 147456, XST_OFF = 146432;

__device__ __forceinline__ float shx(float v, int o, int lane) { return __builtin_bit_cast(float, __builtin_amdgcn_ds_bpermute((lane ^ o) << 2, __builtin_bit_cast(int, v))); }

__device__ __forceinline__ void t_decode(int it, const Params& p, bf16_t* WT1, bf16_t* WT2, bf16_t* WT3, int lane, const float*& src, int& N, bf16_t*& dst) {
  constexpr int I_IN = 32 * (INC / 32), I_GM = 32 * (GMC / 32), I_BR = 4 * 8 * 64, I_OUT = 32 * 64, I_L = I_IN + I_GM + I_BR + I_OUT;
  const int l = DEPTH - 1 - it / I_L; int r = it % I_L; const float* W; bf16_t* WT; int row_off = 0, coff = 0, perm = 0;
  if (r < I_IN) { W = p.w_in + (size_t)l * DM * INC; N = INC; WT = WT1 + (size_t)l * N1 * DM; perm = 1; }
  else { r -= I_IN;
    if (r < I_GM) { W = p.w_gm + (size_t)l * DM * GMC; N = GMC; WT = WT1 + (size_t)l * N1 * DM; row_off = INC; perm = 2; }
    else { r -= I_GM;
      if (r < I_BR) { const int n = r >> 9; r &= 511; W = p.w_branch + (size_t)(l * 4 + n) * 512 * DM; N = DM; WT = WT2 + (size_t)l * DM * DM; coff = n * 512; }
      else { r -= I_BR; W = p.w_out + (size_t)l * DM * DM; N = DM; WT = WT3 + (size_t)l * DM * DM; } } }
  const int nblk = N >> 5, kb = r / nblk, nb = r % nblk, k0 = 64 * kb, c = lane & 7, n = 32 * nb + 4 * (lane >> 3);
  src = W + (size_t)(k0 + 8 * c) * N + n;
  dst = WT + (size_t)(row_off + (perm == 1 ? pg8::g1_row(n) : (perm == 2 ? pg8::gm_row(n) : n))) * DM + coff + k0 + 8 * c;
}

__global__ void __launch_bounds__(512) mega_fwd(Params p) {
  extern __shared__ __attribute__((aligned(16))) unsigned char lds_raw[];
  LAS unsigned char* lds = (LAS unsigned char*)lds_raw;
  cg::grid_group grid = cg::this_grid();
  const int G = gridDim.x, cb = blockIdx.x, NGW = G * 8;
  volatile LAS unsigned* xst = (volatile LAS unsigned*)(lds + XST_OFF);
  if (threadIdx.x < 2) xst[threadIdx.x] = 0u;
  __syncthreads();
  if (blockIdx.x == 0) for (int i = threadIdx.x; i < 4096; i += 512) ((unsigned*)(p.ws + WS_BAR))[i] = 0u;
  XcdBarrier xbar;
  unsigned long long tp0 = 0, tpacc = 0; (void)tp0; (void)tpacc;
  TB(1);
#define PHASE_IDS int tid = threadIdx.x; asm volatile("" : "+v"(tid)); const int lane = tid & 63, wave = __builtin_amdgcn_readfirstlane(tid >> 6), gw = cb * 8 + wave; (void)lane; (void)gw;
  unsigned char* ws = p.ws;
  bf16_t* WT1 = (bf16_t*)(ws + WS_WT1); bf16_t* WT2 = (bf16_t*)(ws + WS_WT2); bf16_t* WT3 = (bf16_t*)(ws + WS_WT3);
  bf16_t* HB = (bf16_t*)(ws + WS_H); bf16_t* YB = HB; bf16_t* QKVG = (bf16_t*)(ws + WS_QKVG); bf16_t* MERGED = QKVG; bf16_t* MG = (bf16_t*)(ws + WS_MG);
  bf16_t* PO = (bf16_t*)(ws + WS_PO); float* PLSE = (float*)(ws + WS_PLSE); float* ADA = (float*)(ws + WS_ADA); bf16_t* XB = (bf16_t*)(ws + WS_XB);

  {
    PHASE_IDS
    LAS float* sc = (LAS float*)lds; LAS float* red = (LAS float*)(lds + 16384);
    for (int i = tid; i < NB * DM; i += 512) { const float v = p.c[i]; sc[i] = v * sigmoidf_(v); }
    __syncthreads();
    for (int u = cb; u < DEPTH * 64; u += G) {
      const int l = u >> 6, jb = u & 63;
      if (tid < 384) { const int qd = tid % 24, kg = tid / 24;
        const float* W = p.w_ada + (size_t)l * DM * (3 * DM) + jb * 96 + 4 * qd + (size_t)(kg * 128) * (3 * DM);
        f32x4 a0 = {0.f, 0.f, 0.f, 0.f}, a1 = {0.f, 0.f, 0.f, 0.f};
#pragma unroll 8
        for (int k = 0; k < 128; ++k) { const f32x4 w = __builtin_nontemporal_load((const f32x4*)(W + (size_t)k * (3 * DM))); a0 += w * sc[kg * 128 + k]; a1 += w * sc[DM + kg * 128 + k]; }
        *(LAS f32x4*)(red + (kg * 2 + 0) * 96 + 4 * qd) = a0; *(LAS f32x4*)(red + (kg * 2 + 1) * 96 + 4 * qd) = a1; }
      __syncthreads();
      if (tid < 192) { const int b = tid / 96, cc = tid % 96; float s = 0.f;
#pragma unroll
        for (int w = 0; w < 16; ++w) s += red[(w * 2 + b) * 96 + cc];
        ADA[(size_t)(l * NB + b) * (3 * DM) + jb * 96 + cc] = s + p.b_ada[l * 3 * DM + jb * 96 + cc]; }
      __syncthreads();
    }
    constexpr int T_TOT = DEPTH * (32 * (INC / 32) + 32 * (GMC / 32) + 4 * 8 * 64 + 32 * 64);
    for (int it0 = gw; it0 < T_TOT; it0 += 2 * NGW) {
      const float* s0; const float* s1; int n0_, n1_; bf16_t* d0; bf16_t* d1;
      const bool has1 = it0 + NGW < T_TOT;
      t_decode(it0, p, WT1, WT2, WT3, lane, s0, n0_, d0); t_decode(has1 ? it0 + NGW : it0, p, WT1, WT2, WT3, lane, s1, n1_, d1);
      f32x4 v0[8], v1[8];
#pragma unroll
      for (int i = 0; i < 8; ++i) { v0[i] = __builtin_nontemporal_load((const f32x4*)(s0 + (size_t)i * n0_)); v1[i] = __builtin_nontemporal_load((const f32x4*)(s1 + (size_t)i * n1_)); }
#pragma unroll
      for (int e = 0; e < 4; ++e) { u32x4 o; o.x = cvt_pk_bf16(v0[0][e], v0[1][e]); o.y = cvt_pk_bf16(v0[2][e], v0[3][e]); o.z = cvt_pk_bf16(v0[4][e], v0[5][e]); o.w = cvt_pk_bf16(v0[6][e], v0[7][e]);
        *(u32x4*)(d0 + (size_t)e * DM) = o; }
      if (has1) {
#pragma unroll
        for (int e = 0; e < 4; ++e) { u32x4 o; o.x = cvt_pk_bf16(v1[0][e], v1[1][e]); o.y = cvt_pk_bf16(v1[2][e], v1[3][e]); o.z = cvt_pk_bf16(v1[4][e], v1[5][e]); o.w = cvt_pk_bf16(v1[6][e], v1[7][e]);
          *(u32x4*)(d1 + (size_t)e * DM) = o; } }
    }
  }
  grid.sync();
  xbar = xcd_barrier_post((unsigned*)(p.ws + WS_BAR), xst);
  TE(1);

#pragma unroll 1
  for (int l = 0; l < DEPTH; ++l) {
    TB(2);
    for (int rep = 0; rep < REPS(4); ++rep) { PHASE_IDS
    for (int row0 = gw; row0 < NTOK; row0 += 4 * NGW) {
      f32x4 v[4][8]; float ss[4];
      if (l == 0) {
#pragma unroll
        for (int k = 0; k < 4; ++k) { const int row = (row0 + k * NGW < NTOK) ? row0 + k * NGW : row0;
          const f32x4* xr = (const f32x4*)(p.x + (size_t)row * DM) + 2 * lane;
#pragma unroll
          for (int j = 0; j < 4; ++j) { v[k][2 * j] = xr[128 * j]; v[k][2 * j + 1] = xr[128 * j + 1]; } }
      } else {
#pragma unroll
        for (int k = 0; k < 4; ++k) { const int row = (row0 + k * NGW < NTOK) ? row0 + k * NGW : row0;
          const u32x4* xr = (const u32x4*)(XB + (size_t)row * DM) + lane;
#pragma unroll
          for (int j = 0; j < 4; ++j) { const u32x4 r = xr[64 * j];
            v[k][2 * j] = (f32x4){bf_lo(r.x), bf_hi(r.x), bf_lo(r.y), bf_hi(r.y)}; v[k][2 * j + 1] = (f32x4){bf_lo(r.z), bf_hi(r.z), bf_lo(r.w), bf_hi(r.w)}; } }
      }
#pragma unroll
      for (int k = 0; k < 4; ++k) { float s = 0.f;
#pragma unroll
        for (int j = 0; j < 8; ++j) s += (v[k][j].x * v[k][j].x + v[k][j].y * v[k][j].y) + (v[k][j].z * v[k][j].z + v[k][j].w * v[k][j].w);
        ss[k] = s; }
#pragma unroll
      for (int o = 1; o < 64; o <<= 1) {
#pragma unroll
        for (int k = 0; k < 4; ++k) ss[k] += shx(ss[k], o, lane); }
#pragma unroll
      for (int k = 0; k < 4; ++k) { const int row = row0 + k * NGW; if (row < NTOK) {
        const float rstd = rsqrtf(ss[k] * (1.f / DM) + EPS);
        const float* ad = ADA + (size_t)(l * NB + (row >> 13)) * (3 * DM);
        u32x4* o16 = (u32x4*)(HB + (size_t)row * DM) + lane;
#pragma unroll
        for (int j = 0; j < 4; ++j) { const int col = (64 * j + lane) * 8; u32x4 w;
#pragma unroll
          for (int hh = 0; hh < 2; ++hh) { const int cc = col + 4 * hh;
            const f32x4 g = *(const f32x4*)(p.norm_g + l * DM + cc), sh = *(const f32x4*)(ad + cc), scl = *(const f32x4*)(ad + DM + cc);
            const f32x4 y = (v[k][2 * j + hh] * rstd * g) * (scl + 1.0f) + sh;
            if (hh == 0) { w.x = cvt_pk_bf16(y.x, y.y); w.y = cvt_pk_bf16(y.z, y.w); } else { w.z = cvt_pk_bf16(y.x, y.y); w.w = cvt_pk_bf16(y.z, y.w); } }
          o16[64 * j] = w; } } }
    } }
    GSYNC();
    TE(2); TB(3);
#if PH_G1
    for (int rep = 0; rep < REPS(2); ++rep) { pg8::Gemm g{HB, WT1 + (size_t)l * N1 * DM, DM, DM}; pg8::Order S; S.init(NTOK, N1, G, cb, 0, 1);
      pg8::EpiG1 E{QKVG, MG}; pg8::gemm_phase<pg8::EpiG1>(lds, g, S, E); }
#endif
    GSYNC();
    TE(3); TB(4);
    for (int rep = 0; rep < REPS(3); ++rep) { PHASE_IDS
    for (int it0 = gw; it0 < NTOK * 6 / 8; it0 += 2 * NGW) {
      const int j8 = lane & 7, part = j8 >> 2, sub = j8 & 3, e0 = part * 64 + 8 * sub;
      const f32x4 iv0 = *(const f32x4*)(INV32 + 8 * sub), iv1 = *(const f32x4*)(INV32 + 8 * sub + 4);
      u32x4 ra[2], rb[2]; bf16_t* bp[2]; int tk[2], isk_[2]; bool act[2];
#pragma unroll
      for (int k = 0; k < 2; ++k) { const int it = it0 + k * NGW; act[k] = it < NTOK * 6 / 8; const int H = (act[k] ? it : it0) * 8 + (lane >> 3);
        const int tok = H / 6, h6 = H - tok * 6; tk[k] = tok; isk_[k] = h6 >= 4;
        bp[k] = QKVG + (size_t)tok * INC + (h6 >= 4 ? KC + (h6 - 4) * 128 : QC + h6 * 128) + e0;
        ra[k] = *(const u32x4*)bp[k]; rb[k] = *(const u32x4*)(bp[k] + 32); }
#pragma unroll
      for (int k = 0; k < 2; ++k) { const int s = tk[k] & (SEQ - 1); const float pos = part ? (float)(s & 63) : (float)(s >> 6);
        float a[8] = {bf_lo(ra[k].x), bf_hi(ra[k].x), bf_lo(ra[k].y), bf_hi(ra[k].y), bf_lo(ra[k].z), bf_hi(ra[k].z), bf_lo(ra[k].w), bf_hi(ra[k].w)};
        float b[8] = {bf_lo(rb[k].x), bf_hi(rb[k].x), bf_lo(rb[k].y), bf_hi(rb[k].y), bf_lo(rb[k].z), bf_hi(rb[k].z), bf_lo(rb[k].w), bf_hi(rb[k].w)};
        float ss = 0.f;
#pragma unroll
        for (int j = 0; j < 8; ++j) ss += a[j] * a[j] + b[j] * b[j];
        ss += shx(ss, 1, lane); ss += shx(ss, 2, lane); ss += shx(ss, 4, lane);
        const float rstd = rsqrtf(ss * (1.f / 128.f) + EPS); const float* wn = (isk_[k] ? p.c_k_norm : p.c_q_norm) + l * 128 + e0;
        const f32x4 wa0 = *(const f32x4*)wn, wa1 = *(const f32x4*)(wn + 4), wb0 = *(const f32x4*)(wn + 32), wb1 = *(const f32x4*)(wn + 36);
        float oa[8], ob[8];
#pragma unroll
        for (int j = 0; j < 8; ++j) { const float av = a[j] * rstd * (j < 4 ? wa0[j & 3] : wa1[j & 3]), bv = b[j] * rstd * (j < 4 ? wb0[j & 3] : wb1[j & 3]);
          const float ang = pos * (j < 4 ? iv0[j & 3] : iv1[j & 3]); double rev = (double)ang * 0.15915494309189535; rev -= __builtin_rint(rev);
          const float fr = (float)rev, sn = __builtin_amdgcn_sinf(fr), cs = __builtin_amdgcn_cosf(fr);
          oa[j] = av * cs - bv * sn; ob[j] = bv * cs + av * sn; }
        u32x4 wa, wb; wa.x = cvt_pk_bf16(oa[0], oa[1]); wa.y = cvt_pk_bf16(oa[2], oa[3]); wa.z = cvt_pk_bf16(oa[4], oa[5]); wa.w = cvt_pk_bf16(oa[6], oa[7]);
        wb.x = cvt_pk_bf16(ob[0], ob[1]); wb.y = cvt_pk_bf16(ob[2], ob[3]); wb.z = cvt_pk_bf16(ob[4], ob[5]); wb.w = cvt_pk_bf16(ob[6], ob[7]);
        if (act[k]) { *(u32x4*)bp[k] = wa; *(u32x4*)(bp[k] + 32) = wb; } }
    }
    for (int u = cb; u < 1024; u += G) {
#if PH_A
      if (u < 256) {
        const int x = u & 7, b = (x >> 2) & 1, kvh = (x >> 1) & 1, qb = (x & 1) * 32 + ((u >> 3) & 31), q0 = qb * 128;
        int lo = q0 - 128; if (lo < 0) lo = 0; int hi = q0 + 256; if (hi > SEQ) hi = SEQ;
        const size_t t0 = (size_t)b * SEQ + q0, k0 = (size_t)b * SEQ + lo;
        att::MaskBand mk{lo - q0, 128}; att::OutGated og{YB + t0 * DM + 0 * 512 + (2 * kvh) * 128, QKVG + t0 * INC + GA + (2 * kvh) * 128};
        att::attn_unit<att::MaskBand, att::OutGated, 2, true>(QKVG + t0 * INC + QA + (2 * kvh) * 128, QKVG + k0 * INC + KA + kvh * 128, QKVG + k0 * INC + VA + kvh * 128, INC, INC, (hi - lo) >> 6,
                       p.a_sink[l * 4 + 2 * kvh] * (1.0f / att::SCALE), 1.0f, mk, og, (LAS char*)lds, p.a_sink[l * 4 + 2 * kvh + 1] * (1.0f / att::SCALE));
      } else
#endif
#if PH_B
      if (u >= 256 && u < 768) {
        const int v = u - 256, grp = v >> 8, b = (v >> 2) & 1, h = v & 3, blk = (v >> 3) & 31;
        if (grp == 0) {
          const int q0 = blk * 256; int lo = q0 - 256; if (lo < 0) lo = 0; int hi = q0 + 512; if (hi > SEQ) hi = SEQ;
          const size_t t0 = (size_t)b * SEQ + q0, k0 = (size_t)b * SEQ + lo;
          att::MaskBand2 mk{lo - q0}; att::OutPartial op{PO + ((size_t)0 * NTOK + t0) * 512 + h * 128, PLSE + ((size_t)0 * NTOK + t0) * 4 + h, 1};
          att::attn_unit(QKVG + t0 * INC + QB_ + h * 128, QKVG + k0 * INC + KB_ + h * 128, QKVG + k0 * INC + VB_ + h * 128, INC, INC, (hi - lo) >> 6,
                         att::MFLOOR, 0.0f, mk, op, (LAS char*)lds);
        } else {
          const int pt = 2, dsh = 4, dil = 16, L = SEQ >> dsh, bpr = L >> 8;
          const int r = blk / bpr, lb = blk % bpr, l0 = lb * 256;
          int lo = l0 - 64; if (lo < 0) lo = 0; int hi = l0 + 320; if (hi > L) hi = L;
          const size_t t0 = (size_t)b * SEQ + r + (size_t)dil * l0, k0 = (size_t)b * SEQ + r + (size_t)dil * lo;
          att::MaskBand mk{lo - l0, 64}; att::OutPartial op{PO + ((size_t)pt * NTOK + t0) * 512 + h * 128, PLSE + ((size_t)pt * NTOK + t0) * 4 + h, dil};
          att::attn_unit<att::MaskBand, att::OutPartial, 2, false, true>(QKVG + t0 * INC + QB_ + h * 128, QKVG + k0 * INC + KB_ + h * 128, QKVG + k0 * INC + VB_ + h * 128, INC * dil, INC * dil, (hi - lo) >> 6,
                         att::MFLOOR, 0.0f, mk, op, (LAS char*)lds);
        }
      } else
#endif
#if PH_D
      if (u >= 768) {
        const int v = u - 768, b = (v >> 2) & 1, h = v & 3, blk = (v >> 3) & 31, r0 = blk * 4;
        int lo = r0 - 4; lo = lo < 0 ? 0 : (lo > 120 ? 120 : lo); int hi = r0 + 3 - 4; hi = (hi < 0 ? 0 : (hi > 120 ? 120 : hi)) + 8;
        LAS float* tab = (LAS float*)(lds + att::TAB_OFF);
        __syncthreads();
        for (int i = tid; i < 15 * 128; i += 512) { const int dr = i >> 7, dc = (i & 127) - 63;
          tab[i] = (dc >= -15 && dc <= 15) ? p.d_rel_bias[(size_t)(l * 4 + h) * 465 + dr * 31 + dc + 15] * (1.0f / att::SCALE) : 0.f; }
        __syncthreads();
        const size_t t0 = (size_t)b * SEQ + r0 * 64, k0 = (size_t)b * SEQ + lo * 64;
        att::MaskNA mk{r0, lo, tab}; att::OutGated og{YB + t0 * DM + 3 * 512 + h * 128, QKVG + t0 * INC + GD + h * 128};
if ((hi - lo) & 1)         att::attn_unit<att::MaskNA, att::OutGated, 2, false, true>(QKVG + t0 * INC + QD + h * 128, QKVG + k0 * INC + KD + h * 128, QKVG + k0 * INC + VD + h * 128, INC, INC, hi - lo,
                       att::MFLOOR, 0.0f, mk, og, (LAS char*)lds);
        else         att::attn_unit<att::MaskNA, att::OutGated, 2>(QKVG + t0 * INC + QD + h * 128, QKVG + k0 * INC + KD + h * 128, QKVG + k0 * INC + VD + h * 128, INC, INC, hi - lo,
                       att::MFLOOR, 0.0f, mk, og, (LAS char*)lds);
      }
#endif
      {}
    } }
    GSYNC();
    TE(4); TB(5);
    for (int rep = 0; rep < REPS(4); ++rep) { PHASE_IDS
    for (int tok0 = gw; tok0 < NTOK; tok0 += 4 * NGW) {
      const int h = lane >> 4, c8 = (lane & 15) * 8;
      float ls[4][2]; u32x4 ov[4][2], gg[4];
#pragma unroll
      for (int k = 0; k < 4; ++k) { const int tok = (tok0 + k * NGW < NTOK) ? tok0 + k * NGW : tok0;
#pragma unroll
        for (int ps = 0; ps < 2; ++ps) { const int pt = 2 * ps; ls[k][ps] = PLSE[((size_t)pt * NTOK + tok) * 4 + h]; ov[k][ps] = *(const u32x4*)(PO + ((size_t)pt * NTOK + tok) * 512 + h * 128 + c8); }
        gg[k] = *(const u32x4*)(QKVG + (size_t)tok * INC + GB_ + h * 128 + c8); }
#pragma unroll
      for (int k = 0; k < 4; ++k) { const int tok = tok0 + k * NGW; if (tok < NTOK) {
        const float mx = fmaxf(ls[k][0], ls[k][1]); float w0 = __expf(ls[k][0] - mx), w1 = __expf(ls[k][1] - mx);
        const float rs = 1.0f / (w0 + w1); w0 *= rs; w1 *= rs;
        u32x4 y;
#define CMB(F) cvt_pk_bf16((w0 * bf_lo(ov[k][0].F) + w1 * bf_lo(ov[k][1].F)) * bf_lo(gg[k].F), (w0 * bf_hi(ov[k][0].F) + w1 * bf_hi(ov[k][1].F)) * bf_hi(gg[k].F))
        y.x = CMB(x); y.y = CMB(y); y.z = CMB(z); y.w = CMB(w);
#undef CMB
        *(u32x4*)(YB + (size_t)tok * DM + 1 * 512 + h * 128 + c8) = y; } }
    } }
#if PH_C
    for (int rep = 0; rep < REPS(3) * REPS(6); ++rep)
    for (int u = cb; u < 256; u += G) {
      const int xcd = u & 7, idx = u >> 3, pair = xcd >> 1, b = pair >> 1, kvh = pair & 1, hq = kvh * 2 + (xcd & 1), q0 = idx * 256;
      const size_t t0 = (size_t)b * SEQ + q0, k0 = (size_t)b * SEQ;
      att::MaskNone mk; att::OutGated og{YB + t0 * DM + 2 * 512 + hq * 128, QKVG + t0 * INC + GC + hq * 128};
      att::attn_unit(QKVG + t0 * INC + QC + hq * 128, QKVG + k0 * INC + KC + kvh * 128, QKVG + k0 * INC + VC + kvh * 128, INC, INC, SEQ / 64,
                     att::MFLOOR, 0.0f, mk, og, (LAS char*)lds);
    }
#endif
    GSYNC();
    TE(5); TB(6);
#if PH_G2
    for (int rep = 0; rep < REPS(5); ++rep) { pg8::Gemm g{YB, WT2 + (size_t)l * DM * DM, DM, DM}; pg8::Order S; S.init(NTOK, DM, G, cb, 0);
      pg8::EpiG2 E{MG, MERGED}; pg8::gemm_phase<pg8::EpiG2>(lds, g, S, E); }
#endif
    GSYNC();
    TE(6); TB(7);
#if PH_G3
    { pg8::Gemm g{MERGED, WT3 + (size_t)l * DM * DM, DM, DM}; pg8::Order S; S.init(NTOK, DM, G, cb, 0);
      pg8::EpiG3 E{(l == 0) ? p.x : (const float*)nullptr, XB, ADA + (size_t)(l * NB) * (3 * DM) + 2 * DM}; pg8::gemm_phase<pg8::EpiG3>(lds, g, S, E); }
#endif
    GSYNC();
    TE(7);
  }
  TB(8);
  { PHASE_IDS
  for (int row0 = gw; row0 < NTOK; row0 += 4 * NGW) {
    f32x4 v[4][8]; float ss[4];
#pragma unroll
    for (int k = 0; k < 4; ++k) { const int row = (row0 + k * NGW < NTOK) ? row0 + k * NGW : row0;
      const u32x4* xr = (const u32x4*)(XB + (size_t)row * DM) + lane;
#pragma unroll
      for (int j = 0; j < 4; ++j) { const u32x4 r = xr[64 * j];
        v[k][2 * j] = (f32x4){bf_lo(r.x), bf_hi(r.x), bf_lo(r.y), bf_hi(r.y)}; v[k][2 * j + 1] = (f32x4){bf_lo(r.z), bf_hi(r.z), bf_lo(r.w), bf_hi(r.w)}; } }
#pragma unroll
    for (int k = 0; k < 4; ++k) { float s = 0.f;
#pragma unroll
      for (int j = 0; j < 8; ++j) s += (v[k][j].x * v[k][j].x + v[k][j].y * v[k][j].y) + (v[k][j].z * v[k][j].z + v[k][j].w * v[k][j].w);
      ss[k] = s; }
#pragma unroll
    for (int o = 1; o < 64; o <<= 1) {
#pragma unroll
      for (int k = 0; k < 4; ++k) ss[k] += shx(ss[k], o, lane); }
#pragma unroll
    for (int k = 0; k < 4; ++k) { const int row = row0 + k * NGW; if (row < NTOK) {
      const float rstd = rsqrtf(ss[k] * (1.f / DM) + EPS);
      f32x4* xw = (f32x4*)(p.out + (size_t)row * DM) + 2 * lane;
#pragma unroll
      for (int j = 0; j < 4; ++j) { const int col = (64 * j + lane) * 8;
        const f32x4 g0 = *(const f32x4*)(p.final_g + col), g1 = *(const f32x4*)(p.final_g + col + 4);
        __builtin_nontemporal_store(v[k][2 * j] * rstd * g0, xw + 128 * j); __builtin_nontemporal_store(v[k][2 * j + 1] * rstd * g1, xw + 128 * j + 1); } } }
  } }
  if (TPROBE != 0) { __syncthreads(); TE(8);
    if (blockIdx.x == 0 && threadIdx.x == 0) { const unsigned long long ts = __builtin_amdgcn_s_memrealtime(); while (__builtin_amdgcn_s_memrealtime() - ts < tpacc) __builtin_amdgcn_s_sleep(32); } }
}

extern "C" void kernel_launch(void* const* d_in, const int* in_sizes, int n_in, void* d_out, int out_size, void* d_ws, size_t ws_size, hipStream_t stream) {
  static int grid_blocks = 0;
  if (grid_blocks == 0) {
    if (n_in != 14 || out_size != NTOK * DM || ws_size < WS_END) { fprintf(stderr, "kernel_launch: unexpected shapes (n_in %d out %d ws %zu need %zu)\n", n_in, out_size, ws_size, (size_t)WS_END); grid_blocks = -1; return; }
    int dev = 0, cus = 0, per_cu = 0;
    hipGetDevice(&dev); hipDeviceGetAttribute(&cus, hipDeviceAttributeMultiprocessorCount, dev);
    if (hipFuncSetAttribute((const void*)mega_fwd, hipFuncAttributeMaxDynamicSharedMemorySize, LDS_BYTES) != hipSuccess) { fprintf(stderr, "kernel_launch: hipFuncSetAttribute failed\n"); grid_blocks = -1; return; }
    hipOccupancyMaxActiveBlocksPerMultiprocessor(&per_cu, (const void*)mega_fwd, 512, LDS_BYTES);
    (void)hipGetLastError();
    if (per_cu < 1) per_cu = 1;
    grid_blocks = cus * 1;
  }
  if (grid_blocks < 0) return;
  Params p{};
  p.x = (const float*)d_in[0]; p.c = (const float*)d_in[1]; p.norm_g = (const float*)d_in[2]; p.w_ada = (const float*)d_in[3]; p.b_ada = (const float*)d_in[4];
  p.w_in = (const float*)d_in[5]; p.a_sink = (const float*)d_in[6]; p.c_q_norm = (const float*)d_in[7]; p.c_k_norm = (const float*)d_in[8]; p.d_rel_bias = (const float*)d_in[9];
  p.w_gm = (const float*)d_in[10]; p.w_branch = (const float*)d_in[11]; p.w_out = (const float*)d_in[12]; p.final_g = (const float*)d_in[13];
  p.out = (float*)d_out; p.ws = (unsigned char*)d_ws;
  void* args[] = {&p};
  hipError_t e = hipLaunchCooperativeKernel((const void*)mega_fwd, dim3(grid_blocks), dim3(512), args, LDS_BYTES, stream);
  if (e != hipSuccess) fprintf(stderr, "cooperative launch failed: %s (grid %d)\n", hipGetErrorString(e), grid_blocks);
}
```
